# Optimizing an MI355X kernel written in HIP

```python
import jax, jax.numpy as jnp
from jax import lax
import numpy as np

D_MODEL = 1024
BATCH = 2
SEQ = 8192
DEPTH = 1

GRID_W = 64
CTX_LEN = 256
N_DIR = 2
D_RWKV = 512
RWKV_HEAD = 64
RWKV_HEADS = D_RWKV // RWKV_HEAD
DECAY_LORA = 64
AAA_LORA = 64
GATE_LORA = 128
D_RET = D_MODEL - D_RWKV
RET_HEADS = 4
RET_HEAD = D_RET // RET_HEADS
RET_CHUNK = 128
RWKV_COLS = 3 * D_RWKV + N_DIR * (DECAY_LORA + AAA_LORA) + GATE_LORA
RET_COLS = 4 * D_RET
IN_COLS = RWKV_COLS + RET_COLS
RWKV_SPLITS = (D_RWKV, 2 * D_RWKV, 3 * D_RWKV, 3 * D_RWKV + N_DIR * DECAY_LORA, 3 * D_RWKV + N_DIR * (DECAY_LORA + AAA_LORA))
N_GROUPS = 4
EXPERTS_PER_GROUP = 8
N_EXPERTS = N_GROUPS * EXPERTS_PER_GROUP
TOP_K_IN_GROUP = 2
EXPERT_HIDDEN = D_MODEL // 2
MOE_BLOCK = 128
ROPE_BASE = 10000.0
LN_EPS = 1e-5
RWKV_GN_EPS = 64e-5
RET_GN_EPS = 1e-5
DEEPNORM_ALPHA = (2.0 * DEPTH) ** 0.25
DEEPNORM_BETA = (8.0 * DEPTH) ** -0.25

kernel_name = 'hybrid_rwkv7_retention_hmoe_dit'


def _layer_norm(z, g, b, eps=LN_EPS):
    zf = z.astype(jnp.float32)
    mu = jnp.mean(zf, axis=-1, keepdims=True)
    var = jnp.mean(jnp.square(zf - mu), axis=-1, keepdims=True)
    return ((zf - mu) * lax.rsqrt(var + eps)).astype(z.dtype) * g + b


def _heads(z, n_heads):
    return z.reshape(z.shape[:-1] + (n_heads, z.shape[-1] // n_heads))


def _head_norm(y, g, b, eps):
    n_heads, dh = y.shape[-2:]
    out = _layer_norm(y, g.reshape(n_heads, dh), b.reshape(n_heads, dh), eps)
    return out.reshape(y.shape[:-2] + (n_heads * dh,))


def _flip_time(z, rev):
    return jnp.flip(z, axis=1) if rev else z


def _qshift_grid(p, rows):
    b, n, ch = p.shape
    g = p.reshape(b, rows, GRID_W, ch // 4, 4)
    left = jnp.pad(g[:, :, :-1, :, 0], ((0, 0), (0, 0), (1, 0), (0, 0)))
    right = jnp.pad(g[:, :, 1:, :, 1], ((0, 0), (0, 0), (0, 1), (0, 0)))
    up = jnp.pad(g[:, :-1, :, :, 2], ((0, 0), (1, 0), (0, 0), (0, 0)))
    down = jnp.pad(g[:, 1:, :, :, 3], ((0, 0), (0, 1), (0, 0), (0, 0)))
    return jnp.stack([left, right, up, down], axis=-1).reshape(b, n, ch)


def _bishift_seq(p):
    b, n, ch = p.shape
    g = p.reshape(b, n, ch // 2, 2)
    prev = jnp.pad(g[:, :-1, :, 0], ((0, 0), (1, 0), (0, 0)))
    nxt = jnp.pad(g[:, 1:, :, 1], ((0, 0), (0, 1), (0, 0)))
    return jnp.stack([prev, nxt], axis=-1).reshape(b, n, ch)


def _rwkv_prepare(pm, w0, w2, a0, a2, g2, k_k, k_a):
    b, n = pm.shape[:2]
    r, k, v, lw, la, lg = jnp.split(pm, RWKV_SPLITS, axis=-1)
    lw = lw.reshape(b, n, N_DIR, DECAY_LORA)
    la = la.reshape(b, n, N_DIR, AAA_LORA)
    w = w0 + jnp.einsum('bldr,drc->bldc', jnp.tanh(lw), w2)
    decay = jnp.exp(-jnp.exp(-jax.nn.softplus(-w) - 0.5))
    a = jax.nn.sigmoid(a0 + jnp.einsum('bldr,drc->bldc', la, a2))
    g = jax.nn.sigmoid(lg) @ g2
    kk = _heads(k * k_k, RWKV_HEADS).astype(jnp.float32)
    kk = (kk / jnp.maximum(jnp.sqrt(jnp.sum(jnp.square(kk), axis=-1, keepdims=True)), 1e-12)).astype(k.dtype)
    k_dir = k[:, :, None, :] * (1.0 + (a - 1.0) * k_a)
    return r, v, kk, decay, a, k_dir, g


def _wkv7_scan(r, w, k, v, kk, a, s0, reverse, emit):
    xs = tuple(jnp.swapaxes(z, 0, 1) for z in (r, w, k, v, kk, a))

    def step(S, inp):
        r_t, w_t, k_t, v_t, kk_t, a_t = inp
        s_kk = jnp.einsum('bhvk,bhk->bhv', S, kk_t)
        S = (S * w_t[:, :, None, :] - s_kk[..., None] * (kk_t * a_t)[:, :, None, :]
             + v_t[..., None] * k_t[:, :, None, :])
        return S, (jnp.einsum('bhvk,bhk->bhv', S, r_t) if emit else None)

    S, ys = lax.scan(step, s0, xs, reverse=reverse)
    return S, (jnp.swapaxes(ys, 0, 1) if emit else None)


def _wkv7_direction(stream, d, s0, reverse, emit):
    r, v, kk, decay, a, k_dir, _ = stream
    H = RWKV_HEADS
    return _wkv7_scan(_heads(r, H), _heads(decay[:, :, d], H), _heads(k_dir[:, :, d], H),
                      _heads(v, H), kk, _heads(a[:, :, d], H), s0, reverse, emit)


def _rwkv_bidir(lat, ctx, emit_ctx):
    b = lat[0].shape[0]
    s0 = jnp.zeros((b, RWKV_HEADS, RWKV_HEAD, RWKV_HEAD), jnp.float32)
    y, yc = 0.0, 0.0
    for d in range(N_DIR):
        rev = d == 1
        s_ctx, y_c_d = _wkv7_direction(ctx, d, s0, rev, emit_ctx)
        _, y_d = _wkv7_direction(lat, d, s_ctx, rev, True)
        y = y + y_d
        if emit_ctx:
            yc = yc + y_c_d
    return y, (yc if emit_ctx else None)


def _rwkv_output(stream, y, r_k, gn_g, gn_b):
    r, v, _, _, _, k_dir, g = stream
    rh = _heads(r, RWKV_HEADS)
    kh = _heads(k_dir, RWKV_HEADS)
    bonus = jnp.sum(rh[:, :, None] * kh * _heads(r_k, RWKV_HEADS), axis=-1, keepdims=True)
    bonus = jnp.sum(bonus, axis=2) * _heads(v, RWKV_HEADS)
    o = _head_norm(y, gn_g, gn_b, RWKV_GN_EPS) + bonus.reshape(bonus.shape[:-2] + (D_RWKV,))
    return o * g


def _rope(z, ang):
    cos = jnp.cos(ang)[None, :, None, :].astype(z.dtype)
    sin = jnp.sin(ang)[None, :, None, :].astype(z.dtype)
    z1, z2 = jnp.split(z, 2, axis=-1)
    return jnp.concatenate([z1 * cos - z2 * sin, z1 * sin + z2 * cos], axis=-1)


def _axial_rope(z):
    n, dh = z.shape[1], z.shape[-1]
    nf = dh // 4
    inv = ROPE_BASE ** (-jnp.arange(nf, dtype=jnp.float32) / nf)
    t = jnp.arange(n)
    ang_row = (t // GRID_W).astype(jnp.float32)[:, None] * inv
    ang_col = (t % GRID_W).astype(jnp.float32)[:, None] * inv
    z_row, z_col = jnp.split(z, 2, axis=-1)
    return jnp.concatenate([_rope(z_row, ang_row), _rope(z_col, ang_col)], axis=-1)


def _retention_dir(q, k, v, log_gamma, s0, include_diag, emit):
    b, n_tok, H, dh = k.shape
    n = n_tok // RET_CHUNK
    kc = k.reshape(b, n, RET_CHUNK, H, dh)
    vc = v.reshape(b, n, RET_CHUNK, H, dh)
    j = jnp.arange(RET_CHUNK, dtype=jnp.float32)
    tail = jnp.exp(log_gamma[None, :] * (RET_CHUNK - 1 - j)[:, None])
    U = jnp.einsum('bnjhd,bnjhe->nbhde', kc * tail[:, :, None], vc)
    g_chunk = jnp.exp(log_gamma * RET_CHUNK)[None, :, None, None]

    def step(S, U_n):
        return S * g_chunk + U_n, S

    S_final, S_start = lax.scan(step, s0, U)
    if not emit:
        return S_final, None
    qc = q.reshape(b, n, RET_CHUNK, H, dh)
    rel = j[:, None] - j[None, :]
    mask = rel >= 0 if include_diag else rel > 0
    dmat = jnp.where(mask[None], jnp.exp(log_gamma[:, None, None] * jnp.maximum(rel, 0.0)[None]), 0.0)
    scores = jnp.einsum('bnihd,bnjhd->bnhij', qc, kc) * dmat
    inner = jnp.einsum('bnhij,bnjhe->bnihe', scores, vc)
    head = jnp.exp(log_gamma[None, :] * (j + 1.0)[:, None])
    cross = jnp.einsum('bnihd,nbhde->bnihe', qc * head[:, :, None], S_start)
    return S_final, (inner + cross).reshape(b, n_tok, H, dh)


def _retention_bidir(q, k, v, qc, kc, vc, emit_ctx, ret_decay):
    b = q.shape[0]
    scale = RET_HEAD ** -0.5
    q = _axial_rope(_heads(q, RET_HEADS))
    k = _axial_rope(_heads(k, RET_HEADS)) * scale
    v = _heads(v, RET_HEADS)
    qc = _heads(qc, RET_HEADS)
    kc = _heads(kc, RET_HEADS) * scale
    vc = _heads(vc, RET_HEADS)
    log_gamma = -jax.nn.softplus(ret_decay)
    s0 = jnp.zeros((b, RET_HEADS, RET_HEAD, RET_HEAD), jnp.float32)
    y, yc = 0.0, 0.0
    for d in range(N_DIR):
        rev = d == 1
        s_ctx, y_c_d = _retention_dir(_flip_time(qc, rev), _flip_time(kc, rev), _flip_time(vc, rev),
                                      log_gamma[d], s0, not rev, emit_ctx)
        _, y_d = _retention_dir(_flip_time(q, rev), _flip_time(k, rev), _flip_time(v, rev),
                                log_gamma[d], s_ctx, not rev, True)
        y = y + _flip_time(y_d, rev)
        if emit_ctx:
            yc = yc + _flip_time(y_c_d, rev)
    return y, (yc if emit_ctx else None)


def _token_mixer(u, uc, rows, emit_ctx, w_in, mu, w0, w2, a0, a2, g2, k_k, k_a, r_k,
                 rwkv_gn_g, rwkv_gn_b, ret_decay, ret_gn_g, ret_gn_b, w_out):
    p = u @ w_in
    pc = uc @ w_in
    pr, pt = p[..., :RWKV_COLS], p[..., RWKV_COLS:]
    prc, ptc = pc[..., :RWKV_COLS], pc[..., RWKV_COLS:]
    pr = pr + mu * (_qshift_grid(pr, rows) - pr)
    prc = prc + mu * (_bishift_seq(prc) - prc)
    lat = _rwkv_prepare(pr, w0, w2, a0, a2, g2, k_k, k_a)
    ctx = _rwkv_prepare(prc, w0, w2, a0, a2, g2, k_k, k_a)
    y_rwkv, yc_rwkv = _rwkv_bidir(lat, ctx, emit_ctx)
    q, k, v, gt = jnp.split(pt, 4, axis=-1)
    qc, kc, vc, gtc = jnp.split(ptc, 4, axis=-1)
    y_ret, yc_ret = _retention_bidir(q, k, v, qc, kc, vc, emit_ctx, ret_decay)
    o_rwkv = _rwkv_output(lat, y_rwkv, r_k, rwkv_gn_g, rwkv_gn_b)
    o_ret = _head_norm(y_ret, ret_gn_g, ret_gn_b, RET_GN_EPS) * jax.nn.silu(gt)
    out = jnp.concatenate([o_rwkv, o_ret], axis=-1) @ w_out
    if not emit_ctx:
        return out, None
    oc_rwkv = _rwkv_output(ctx, yc_rwkv, r_k, rwkv_gn_g, rwkv_gn_b)
    oc_ret = _head_norm(yc_ret, ret_gn_g, ret_gn_b, RET_GN_EPS) * jax.nn.silu(gtc)
    return out, jnp.concatenate([oc_rwkv, oc_ret], axis=-1) @ w_out


def _grouped_experts(u, expert_ids, gates, w_gate, w_up, w_down):
    n_tok, d = u.shape
    n_assign = n_tok * TOP_K_IN_GROUP
    n_blk = -(-n_assign // MOE_BLOCK) + N_EXPERTS
    n_slot = n_blk * MOE_BLOCK
    flat_e = expert_ids.reshape(-1).astype(jnp.int32)
    flat_gate = gates.reshape(-1)
    flat_tok = jnp.repeat(jnp.arange(n_tok, dtype=jnp.int32), TOP_K_IN_GROUP)
    order = jnp.argsort(flat_e)
    e_sorted = flat_e[order]
    counts = jax.ops.segment_sum(jnp.ones_like(flat_e), flat_e, num_segments=N_EXPERTS)
    padded = ((counts + MOE_BLOCK - 1) // MOE_BLOCK) * MOE_BLOCK
    starts = jnp.cumsum(counts) - counts
    pends = jnp.cumsum(padded)
    pstarts = pends - padded
    dest = pstarts[e_sorted] + (jnp.arange(n_assign, dtype=jnp.int32) - starts[e_sorted])
    slot_tok = jnp.zeros((n_slot,), jnp.int32).at[dest].set(flat_tok[order])
    slot_gate = jnp.zeros((n_slot,), gates.dtype).at[dest].set(flat_gate[order])
    block_start = jnp.arange(n_blk, dtype=jnp.int32) * MOE_BLOCK
    block_expert = jnp.minimum(jnp.searchsorted(pends, block_start, side='right'), N_EXPERTS - 1)

    def run_block(blk):
        toks, gts, e = blk
        h = u[toks]
        y = (jax.nn.silu(h @ w_gate[e]) * (h @ w_up[e])) @ w_down[e]
        return y * gts[:, None]

    ys = lax.map(run_block, (slot_tok.reshape(n_blk, MOE_BLOCK), slot_gate.reshape(n_blk, MOE_BLOCK), block_expert))
    return jnp.zeros_like(u).at[slot_tok].add(ys.reshape(n_slot, d))


def _hier_moe(u, router_g, bias_g, router_e, bias_e, w_gate, w_up, w_down):
    n_tok = u.shape[0]
    gp = jax.nn.softmax((u @ router_g + bias_g).astype(jnp.float32), axis=-1)
    g_w, g_i = lax.top_k(gp, 1)
    el = (u @ router_e).reshape(n_tok, N_GROUPS, EXPERTS_PER_GROUP) + bias_e
    el = jnp.take_along_axis(el, g_i[:, :, None], axis=1)[:, 0].astype(jnp.float32)
    ep = jax.nn.softmax(el, axis=-1)
    top_p, top_i = lax.top_k(ep, TOP_K_IN_GROUP)
    gates = g_w * top_p / jnp.sum(top_p, axis=-1, keepdims=True)
    expert_ids = g_i * EXPERTS_PER_GROUP + top_i
    return _grouped_experts(u, expert_ids, gates.astype(u.dtype), w_gate, w_up, w_down)


def setup_inputs(seed: int = 0) -> dict:
    key = jax.random.key(seed)
    ks = jax.random.split(key, 40)
    f32 = jnp.float32
    L = DEPTH

    def nrm(k, shape, scale):
        return jax.random.normal(k, shape, f32) * scale

    base_gamma = 1.0 - 2.0 ** (-5.0 - jnp.arange(RET_HEADS, dtype=f32))
    neg_log_gamma = -jnp.log(base_gamma) * (1.0 + nrm(ks[20], (L, N_DIR, RET_HEADS), 0.05))
    decay_base = jnp.linspace(-6.5, -1.5, D_RWKV, dtype=f32)
    return {
        'x': nrm(ks[0], (BATCH, SEQ, D_MODEL), 1.0),
        'c': nrm(ks[1], (BATCH, D_MODEL), 1.0),
        'ctx': nrm(ks[2], (BATCH, CTX_LEN, D_MODEL), 1.0),
        'c_ctx': nrm(ks[3], (D_MODEL,), 1.0),
        'emb_ln_g': 1.0 + nrm(ks[4], (D_MODEL,), 0.02),
        'emb_ln_b': nrm(ks[5], (D_MODEL,), 0.02),
        'w_mod': nrm(ks[6], (L, D_MODEL, 6 * D_MODEL), 0.5 * D_MODEL ** -0.5),
        'b_mod': nrm(ks[7], (L, 6 * D_MODEL), 0.02),
        'w_in': nrm(ks[8], (L, D_MODEL, IN_COLS), D_MODEL ** -0.5),
        'tshift_mu': jax.random.uniform(ks[9], (L, RWKV_COLS), f32, 0.0, 1.0),
        'rwkv_w0': decay_base + nrm(ks[10], (L, N_DIR, D_RWKV), 0.1),
        'rwkv_w2': nrm(ks[11], (L, N_DIR, DECAY_LORA, D_RWKV), 0.5 * DECAY_LORA ** -0.5),
        'rwkv_a0': nrm(ks[12], (L, N_DIR, D_RWKV), 0.1),
        'rwkv_a2': nrm(ks[13], (L, N_DIR, AAA_LORA, D_RWKV), 0.5 * AAA_LORA ** -0.5),
        'rwkv_g2': nrm(ks[14], (L, GATE_LORA, D_RWKV), GATE_LORA ** -0.5),
        'rwkv_k_k': 0.85 + nrm(ks[15], (L, D_RWKV), 0.02),
        'rwkv_k_a': 1.0 + nrm(ks[16], (L, D_RWKV), 0.02),
        'rwkv_r_k': nrm(ks[17], (L, D_RWKV), 0.1),
        'rwkv_gn_g': 1.0 + nrm(ks[18], (L, D_RWKV), 0.02),
        'rwkv_gn_b': nrm(ks[19], (L, D_RWKV), 0.02),
        'ret_decay': jnp.log(jnp.expm1(neg_log_gamma)),
        'ret_gn_g': 1.0 + nrm(ks[21], (L, D_RET), 0.02),
        'ret_gn_b': nrm(ks[22], (L, D_RET), 0.02),
        'w_out': nrm(ks[23], (L, D_MODEL, D_MODEL), DEEPNORM_BETA * D_MODEL ** -0.5),
        'ln1_g': 1.0 + nrm(ks[24], (L, D_MODEL), 0.02),
        'ln1_b': nrm(ks[25], (L, D_MODEL), 0.02),
        'router_group': nrm(ks[26], (L, D_MODEL, N_GROUPS), D_MODEL ** -0.5),
        'router_group_bias': nrm(ks[27], (L, N_GROUPS), 0.01),
        'router_expert': nrm(ks[28], (L, D_MODEL, N_EXPERTS), D_MODEL ** -0.5),
        'router_expert_bias': nrm(ks[29], (L, N_GROUPS, EXPERTS_PER_GROUP), 0.01),
        'expert_w_gate': nrm(ks[30], (L, N_EXPERTS, D_MODEL, EXPERT_HIDDEN), D_MODEL ** -0.5),
        'expert_w_up': nrm(ks[31], (L, N_EXPERTS, D_MODEL, EXPERT_HIDDEN), D_MODEL ** -0.5),
        'expert_w_down': nrm(ks[32], (L, N_EXPERTS, EXPERT_HIDDEN, D_MODEL), DEEPNORM_BETA * EXPERT_HIDDEN ** -0.5),
        'ln2_g': 1.0 + nrm(ks[33], (L, D_MODEL), 0.02),
        'ln2_b': nrm(ks[34], (L, D_MODEL), 0.02),
    }


def reference(x, c, ctx, c_ctx, emb_ln_g, emb_ln_b, w_mod, b_mod, w_in, tshift_mu,
              rwkv_w0, rwkv_w2, rwkv_a0, rwkv_a2, rwkv_g2, rwkv_k_k, rwkv_k_a, rwkv_r_k,
              rwkv_gn_g, rwkv_gn_b, ret_decay, ret_gn_g, ret_gn_b, w_out, ln1_g, ln1_b,
              router_group, router_group_bias, router_expert, router_expert_bias,
              expert_w_gate, expert_w_up, expert_w_down, ln2_g, ln2_b):
    b, n_tok, d = x.shape
    n_ctx = ctx.shape[1]
    rows = n_tok // GRID_W
    h = _layer_norm(x, emb_ln_g, emb_ln_b)
    hc = _layer_norm(ctx, emb_ln_g, emb_ln_b)
    sc = jax.nn.silu(c)
    scc = jax.nn.silu(c_ctx)
    for l in range(DEPTH):
        emit_ctx = l < DEPTH - 1
        mod = sc @ w_mod[l] + b_mod[l]
        modc = scc @ w_mod[l] + b_mod[l]
        sh1, s1, g1, sh2, s2, g2 = jnp.split(mod[:, None, :], 6, axis=-1)
        sh1c, s1c, g1c, sh2c, s2c, g2c = jnp.split(modc, 6)
        u = h * (1.0 + s1) + sh1
        uc = hc * (1.0 + s1c) + sh1c
        mix, mixc = _token_mixer(u, uc, rows, emit_ctx, w_in[l], tshift_mu[l], rwkv_w0[l], rwkv_w2[l],
                                 rwkv_a0[l], rwkv_a2[l], rwkv_g2[l], rwkv_k_k[l], rwkv_k_a[l], rwkv_r_k[l],
                                 rwkv_gn_g[l], rwkv_gn_b[l], ret_decay[l], ret_gn_g[l], ret_gn_b[l], w_out[l])
        h = _layer_norm(DEEPNORM_ALPHA * h + g1 * mix, ln1_g[l], ln1_b[l])
        u2 = (h * (1.0 + s2) + sh2).reshape(b * n_tok, d)
        moe_params = (router_group[l], router_group_bias[l], router_expert[l], router_expert_bias[l],
                      expert_w_gate[l], expert_w_up[l], expert_w_down[l])
        if emit_ctx:
            hc = _layer_norm(DEEPNORM_ALPHA * hc + g1c * mixc, ln1_g[l], ln1_b[l])
            u2c = (hc * (1.0 + s2c) + sh2c).reshape(b * n_ctx, d)
            f_all = _hier_moe(jnp.concatenate([u2, u2c], axis=0), *moe_params)
            f = f_all[:b * n_tok].reshape(b, n_tok, d)
            fc = f_all[b * n_tok:].reshape(b, n_ctx, d)
            hc = _layer_norm(DEEPNORM_ALPHA * hc + g2c * fc, ln2_g[l], ln2_b[l])
        else:
            f = _hier_moe(u2, *moe_params).reshape(b, n_tok, d)
        h = _layer_norm(DEEPNORM_ALPHA * h + g2 * f, ln2_g[l], ln2_b[l])
    return h
```

```cpp
#include <hip/hip_runtime.h>
#include <cstdio>
#include <cstdint>
namespace pg8 {
#define PG8_LAS __attribute__((address_space(3)))
typedef unsigned short bf16_t;
typedef short bf16x8 __attribute__((ext_vector_type(8)));
typedef float f32x4 __attribute__((ext_vector_type(4)));
typedef unsigned u32x4 __attribute__((ext_vector_type(4)));
constexpr int BM = 256, BK = 64, HALF = 128, HTB = HALF * BK * 2  , STAGE_BYTES = 8 * HTB, NXCD = 8, WGM = 8;

__host__ __device__ __forceinline__ int lds_byte(int r, int c) { const int st = (r >> 4) * 2 + (c >> 5), rr = r & 15, cc = c & 31, ob = rr * 64 + cc * 2; return st * 1024 + (ob ^ (((ob >> 9) & 1) << 5)); }
__host__ __device__ __forceinline__ void stage_rc(int b, int& R, int& C) { const int st = b / 1024, sb = b % 1024, swz = sb ^ (((sb >> 9) & 1) << 5); R = (st >> 1) * 16 + swz / 64; C = (st & 1) * 32 + (swz % 64) / 2; }
__host__ __device__ __forceinline__ int perm32(int rho) { const int n = rho >> 4, i = rho & 15; return 8 * (i >> 2) + 4 * n + (i & 3); }

struct Unit { int pm, pn; };
struct Gemm { const bf16_t* A; const bf16_t* Bt; int M, N, K, lda; };

struct StaticOrder {
    int nM, nN, nwg, G, c;
    __host__ __device__ void init(int M, int N, int G_, int c_) { nM = M / BM; nN = N / BM; nwg = nM * nN; G = G_; c = c_; }
    __host__ __device__ bool next(int i, Unit& u) const {
        const long L = (long)i * G + c; if (L >= nwg) return false;
        int wgid = (int)L; { const int q = nwg / NXCD, r = nwg % NXCD, xcd = wgid % NXCD, off = wgid / NXCD; wgid = (xcd < r ? xcd * (q + 1) : r * (q + 1) + (xcd - r) * q) + off; }
        const int nig = WGM * nN, gid = wgid / nig, fm = gid * WGM, gsz = (nM - fm) < WGM ? (nM - fm) : WGM;
        u.pm = fm + ((wgid % nig) % gsz); u.pn = (wgid % nig) / gsz; return true;
    }
    __device__ __forceinline__ void a_ready(const Unit&) const {}
    __device__ __forceinline__ void done(const Unit&) const {}
};

__device__ __forceinline__ unsigned cvt_pk_bf16(float lo, float hi) { unsigned r; asm volatile("v_cvt_pk_bf16_f32 %0, %1, %2" : "=v"(r) : "v"(lo), "v"(hi)); return r; }
typedef float f32x2 __attribute__((ext_vector_type(2)));
struct EpiBf16 {
    static constexpr bool PERM = true, AFTER_DRAIN = false;
    bf16_t* O; int ldc;
    __device__ __forceinline__ void operator()(const f32x4 (&acc)[2][2][4][2], const Unit& u, int wr, int wc, int fr, int fq) const {
        const int row0 = u.pm * BM + wr * 64 + fr; const int col0 = u.pn * BM + wc * 32 + 8 * fq;
#pragma unroll
        for (int ai = 0; ai < 2; ++ai)
#pragma unroll
            for (int m = 0; m < 4; ++m) { bf16_t* rowp = O + (size_t)(row0 + ai * HALF + m * 16) * ldc + col0;
#pragma unroll
                for (int bj = 0; bj < 2; ++bj) { const f32x4 v0 = acc[ai][bj][m][0], v1 = acc[ai][bj][m][1];
                    u32x4 w; w.x = cvt_pk_bf16(v0[0], v0[1]); w.y = cvt_pk_bf16(v0[2], v0[3]); w.z = cvt_pk_bf16(v1[0], v1[1]); w.w = cvt_pk_bf16(v1[2], v1[3]);
                    *(u32x4*)(rowp + bj * HALF) = w; } }
    }
};
struct EpiOut {
    static constexpr bool PERM = false, AFTER_DRAIN = false;
    const float* x; const float* stats; const float* eg; const float* eb; const float* mod; float* Z; float alpha;
    __device__ __forceinline__ void operator()(const f32x4 (&acc)[2][2][4][2], const Unit& u, int wr, int wc, int fr, int fq) const {
        const int col0 = u.pn * BM + wc * 32 + 4 * fq;
        const int b = (u.pm * BM) >> 13;
        const float* g1 = mod + (size_t)b * 6144 + 2048;
#pragma unroll
        for (int bj = 0; bj < 2; ++bj)
#pragma unroll
            for (int n = 0; n < 2; ++n) { const int c = col0 + bj * HALF + n * 16;
                const f32x4 vg = *(const f32x4*)(eg + c), vb = *(const f32x4*)(eb + c), v1 = *(const f32x4*)(g1 + c);
#pragma unroll
                for (int ai = 0; ai < 2; ++ai)
#pragma unroll
                    for (int m = 0; m < 4; ++m) { const int r = u.pm * BM + ai * HALF + wr * 64 + m * 16 + fr;
                        const float mean = stats[2 * r], rstd = stats[2 * r + 1];
                        const f32x4 xv = *(const f32x4*)(x + (size_t)r * 1024 + c);
                        f32x4 o = ((xv - mean) * rstd * vg + vb) * alpha + v1 * acc[ai][bj][m][n];
                        *(f32x4*)(Z + (size_t)r * 1024 + c) = o; } }
    }
};
struct EpiGU {
    static constexpr bool PERM = true, AFTER_DRAIN = false;
    bf16_t* Hs;
    __device__ __forceinline__ void operator()(const f32x4 (&acc)[2][2][4][2], const Unit& u, int wr, int wc, int fr, int fq) const {
        const int row0 = u.pm * BM + wr * 64 + fr; const int col0 = (u.pn & 3) * 128 + wc * 32 + 8 * fq;
#pragma unroll
        for (int ai = 0; ai < 2; ++ai)
#pragma unroll
            for (int m = 0; m < 4; ++m) { bf16_t* rowp = Hs + (size_t)(row0 + ai * HALF + m * 16) * 512 + col0;
                float h[8];
#pragma unroll
                for (int n = 0; n < 2; ++n)
#pragma unroll
                    for (int j = 0; j < 4; ++j) { const float g = acc[ai][0][m][n][j], up = acc[ai][1][m][n][j]; h[n * 4 + j] = g / (1.0f + __expf(-g)) * up; }
                u32x4 w; w.x = cvt_pk_bf16(h[0], h[1]); w.y = cvt_pk_bf16(h[2], h[3]); w.z = cvt_pk_bf16(h[4], h[5]); w.w = cvt_pk_bf16(h[6], h[7]);
                *(u32x4*)rowp = w; }
    }
};
struct EpiDown {
    static constexpr bool PERM = true, AFTER_DRAIN = false;
    bf16_t* Ys; const float* sgate;
    __device__ __forceinline__ void operator()(const f32x4 (&acc)[2][2][4][2], const Unit& u, int wr, int wc, int fr, int fq) const {
        const int row0 = u.pm * BM + wr * 64 + fr; const int col0 = (u.pn & 3) * 256 + wc * 32 + 8 * fq;
#pragma unroll
        for (int ai = 0; ai < 2; ++ai)
#pragma unroll
            for (int m = 0; m < 4; ++m) { const int r = row0 + ai * HALF + m * 16; const float gt = sgate[r]; bf16_t* rowp = Ys + (size_t)r * 1024 + col0;
#pragma unroll
                for (int bj = 0; bj < 2; ++bj) { const f32x4 v0 = acc[ai][bj][m][0] * gt, v1 = acc[ai][bj][m][1] * gt;
                    u32x4 w; w.x = cvt_pk_bf16(v0[0], v0[1]); w.y = cvt_pk_bf16(v0[2], v0[3]); w.z = cvt_pk_bf16(v1[0], v1[1]); w.w = cvt_pk_bf16(v1[2], v1[3]);
                    *(u32x4*)(rowp + bj * HALF) = w; } }
    }
};
struct MoeOrder {
    StaticOrder base; const PG8_LAS int* tile_e;
    __device__ __forceinline__ bool next(int i, Unit& u) const { if (!base.next(i, u)) return false; u.pn += 4 * tile_e[u.pm]; return true; }
    __device__ __forceinline__ void a_ready(const Unit&) const {}
    __device__ __forceinline__ void done(const Unit&) const {}
};
template <class Epi, class Sched, bool ALIGN_EPI = false, bool SP2 = false>
__device__ __forceinline__ void gemm_phase(PG8_LAS unsigned char* lds, const Gemm g, const Sched& S, const Epi& E) {
    const int tid = threadIdx.x, wid = __builtin_amdgcn_readfirstlane(tid >> 6), lane = tid & 63, wr = wid >> 2, wc = wid & 3, fr = lane & 15, fq = lane >> 4;
    const int K = g.K, nt = K / BK;
    unsigned voffA[2], voffB[2];
#pragma unroll
    for (int i = 0; i < 2; ++i) { int R, C; stage_rc(tid * 16 + i * 8192, R, C); const int Rb = Epi::PERM ? ((R & ~31) + perm32(R & 31)) : R;
        voffA[i] = (unsigned)(R * g.lda + C) * 2u; voffB[i] = (unsigned)(Rb * K + C) * 2u; }
    const size_t kstep = (size_t)(BK * 2);
    const size_t hstep = (size_t)HALF * K * 2;
    const size_t tstep = 2 * hstep; const size_t hstepA = (size_t)HALF * g.lda * 2, tstepA = 2 * hstepA;
    const unsigned ldsw = (unsigned)wid * 1024u;
    const int aoff = lds_byte(wr * 64 + fr, fq * 8), boff = lds_byte(wc * 32 + fr, fq * 8);
#define PG8_SA(b, h) (((b) * 2 + (h)) * HTB)
#define PG8_SB(b, h) ((4 + (b) * 2 + (h)) * HTB)
#define PG8_STAGE(bufoff, gbase, voff) do { _Pragma("unroll") for (int _i = 0; _i < 2; ++_i) \
        __builtin_amdgcn_global_load_lds((const unsigned*)((const char*)(gbase) + (voff)[_i]), (PG8_LAS unsigned*)(lds + (bufoff) + ldsw + _i * 8192), 16, 0, 0); } while (0)
#define PG8_LDA(dst, b, h) do { _Pragma("unroll") for (int m = 0; m < 4; ++m) _Pragma("unroll") for (int k = 0; k < 2; ++k) dst[m][k] = *(const PG8_LAS bf16x8*)(lds + PG8_SA(b, h) + aoff + m * 2048 + k * 1024); } while (0)
#define PG8_LDB(dst, b, h) do { _Pragma("unroll") for (int n = 0; n < 2; ++n) _Pragma("unroll") for (int k = 0; k < 2; ++k) dst[n][k] = *(const PG8_LAS bf16x8*)(lds + PG8_SB(b, h) + boff + n * 2048 + k * 1024); } while (0)
#define PG8_MMA(ai, bj, At, Bt) do { __builtin_amdgcn_s_setprio(1); _Pragma("unroll") for (int m = 0; m < 4; ++m) _Pragma("unroll") for (int n = 0; n < 2; ++n) _Pragma("unroll") for (int k = 0; k < 2; ++k) \
        acc[ai][bj][m][n] = __builtin_amdgcn_mfma_f32_16x16x32_bf16(Bt[n][k], At[m][k], acc[ai][bj][m][n], 0, 0, 0); __builtin_amdgcn_s_setprio(0); } while (0)
#define PG8_WAIT_V(n) asm volatile("s_waitcnt vmcnt(" #n ")" ::: "memory")
#define PG8_WAIT_L(n) asm volatile("s_waitcnt lgkmcnt(" #n ")" ::: "memory")
#define PG8_BAR __builtin_amdgcn_s_barrier()
#define PG8_SCHED __builtin_amdgcn_sched_barrier(0)
    Unit cur, nxt; int ui = 0;
    if (!S.next(0, cur)) return;
    f32x4 acc[2][2][4][2];
#pragma unroll
    for (int a = 0; a < 2; ++a)
#pragma unroll
        for (int b = 0; b < 2; ++b)
#pragma unroll
            for (int m = 0; m < 4; ++m)
#pragma unroll
                for (int n = 0; n < 2; ++n) acc[a][b][m][n] = (f32x4){0.f, 0.f, 0.f, 0.f};
    bf16x8 At[4][2], B0[2][2], B1[2][2];
    const char* cA = (const char*)g.A + (size_t)cur.pm * tstepA; const char* cB = (const char*)g.Bt + (size_t)cur.pn * tstep;
    S.a_ready(cur);
    if constexpr (SP2) {
        PG8_STAGE(PG8_SB(0, 0), cB, voffB); PG8_STAGE(PG8_SB(0, 1), cB + hstep, voffB); PG8_STAGE(PG8_SA(0, 0), cA, voffA); PG8_STAGE(PG8_SA(0, 1), cA + hstepA, voffA);
        if (wr == 1) PG8_BAR;
        PG8_WAIT_V(2); PG8_BAR;
        PG8_STAGE(PG8_SB(1, 0), cB + kstep, voffB); PG8_STAGE(PG8_SA(1, 0), cA + kstep, voffA); PG8_STAGE(PG8_SB(1, 1), cB + hstep + kstep, voffB);
        PG8_WAIT_V(6); PG8_BAR;
    } else {
        PG8_STAGE(PG8_SB(0, 0), cB, voffB); PG8_STAGE(PG8_SA(0, 0), cA, voffA); PG8_STAGE(PG8_SB(0, 1), cB + hstep, voffB); PG8_STAGE(PG8_SA(0, 1), cA + hstepA, voffA);
        if (wr == 1) PG8_BAR;
        PG8_WAIT_V(4); PG8_BAR;
        PG8_STAGE(PG8_SB(1, 0), cB + kstep, voffB); PG8_STAGE(PG8_SA(1, 0), cA + kstep, voffA); PG8_STAGE(PG8_SB(1, 1), cB + hstep + kstep, voffB);
        PG8_WAIT_V(6); PG8_BAR;
    }
    for (;;) {
        const bool has_next = S.next(ui + 1, nxt);
        const char* nA = has_next ? (const char*)g.A + (size_t)nxt.pm * tstepA : cA; const char* nB = has_next ? (const char*)g.Bt + (size_t)nxt.pn * tstep : cB;
        for (int t = 0; t < nt; t += 2) {
            const bool last = (t == nt - 2);
            const char* a1 = cA + (size_t)(t + 1) * kstep;
            const char* a2 = last ? nA : cA + (size_t)(t + 2) * kstep; const char* b2 = last ? nB : cB + (size_t)(t + 2) * kstep;
            const char* a3 = a2 + kstep; const char* b3 = b2 + kstep;
            if (last && has_next) S.a_ready(nxt);
            if constexpr (SP2) {
            PG8_LDB(B0, 0, 0); PG8_LDB(B1, 0, 1); PG8_SCHED; PG8_LDA(At, 0, 0); PG8_STAGE(PG8_SA(1, 1), a1 + hstepA, voffA);
            PG8_WAIT_V(8); PG8_WAIT_L(0); PG8_BAR; PG8_MMA(0, 0, At, B0); PG8_MMA(0, 1, At, B1); PG8_BAR; PG8_SCHED;
            PG8_LDA(At, 0, 1); PG8_STAGE(PG8_SB(0, 0), b2, voffB); PG8_STAGE(PG8_SB(0, 1), b2 + hstep, voffB); PG8_STAGE(PG8_SA(0, 0), a2, voffA);
            PG8_WAIT_V(8); PG8_WAIT_L(0); PG8_BAR; PG8_MMA(1, 0, At, B0); PG8_MMA(1, 1, At, B1); PG8_BAR; PG8_SCHED;
            PG8_LDB(B0, 1, 0); PG8_LDB(B1, 1, 1); PG8_SCHED; PG8_LDA(At, 1, 0); PG8_STAGE(PG8_SA(0, 1), a2 + hstepA, voffA);
            PG8_WAIT_V(8); PG8_WAIT_L(0); PG8_BAR; PG8_MMA(0, 0, At, B0); PG8_MMA(0, 1, At, B1); PG8_BAR; PG8_SCHED;
            PG8_LDA(At, 1, 1); PG8_STAGE(PG8_SB(1, 0), b3, voffB); PG8_STAGE(PG8_SB(1, 1), b3 + hstep, voffB); PG8_STAGE(PG8_SA(1, 0), a3, voffA);
            PG8_WAIT_V(8); PG8_WAIT_L(0); PG8_BAR; PG8_MMA(1, 0, At, B0); PG8_MMA(1, 1, At, B1); PG8_BAR; PG8_SCHED;
            } else {
            PG8_LDB(B0, 0, 0); PG8_SCHED; PG8_LDA(At, 0, 0); PG8_STAGE(PG8_SA(1, 1), a1 + hstepA, voffA);
            PG8_WAIT_L(8); PG8_BAR; PG8_WAIT_L(0); PG8_MMA(0, 0, At, B0); PG8_BAR; PG8_SCHED;
            PG8_LDB(B1, 0, 1); PG8_STAGE(PG8_SB(0, 0), b2, voffB);
            PG8_BAR; PG8_WAIT_L(0); PG8_MMA(0, 1, At, B1); PG8_BAR;
            PG8_LDA(At, 0, 1); PG8_STAGE(PG8_SA(0, 0), a2, voffA);
            PG8_BAR; PG8_WAIT_L(0); PG8_MMA(1, 0, At, B0); PG8_BAR; PG8_SCHED;
            PG8_STAGE(PG8_SB(0, 1), b2 + hstep, voffB);
            PG8_WAIT_V(6); PG8_BAR; PG8_MMA(1, 1, At, B1); PG8_BAR;
            PG8_LDB(B0, 1, 0); PG8_SCHED; PG8_LDA(At, 1, 0); PG8_STAGE(PG8_SA(0, 1), a2 + hstepA, voffA);
            PG8_WAIT_L(8); PG8_BAR; PG8_WAIT_L(0); PG8_MMA(0, 0, At, B0); PG8_BAR; PG8_SCHED;
            PG8_LDB(B1, 1, 1); PG8_STAGE(PG8_SB(1, 0), b3, voffB);
            PG8_BAR; PG8_WAIT_L(0); PG8_MMA(0, 1, At, B1); PG8_BAR;
            PG8_LDA(At, 1, 1); PG8_STAGE(PG8_SA(1, 0), a3, voffA);
            PG8_BAR; PG8_WAIT_L(0); PG8_MMA(1, 0, At, B0); PG8_BAR; PG8_SCHED;
            PG8_STAGE(PG8_SB(1, 1), b3 + hstep, voffB);
            PG8_WAIT_V(6); PG8_BAR; PG8_MMA(1, 1, At, B1); PG8_BAR;
            }
        }
        if constexpr (ALIGN_EPI) { if (wr == 0) PG8_BAR; }
        if constexpr (!Epi::AFTER_DRAIN) { E(acc, cur, wr, wc, fr, fq); S.done(cur); }
        if (!has_next) break;
#pragma unroll
        for (int a = 0; a < 2; ++a)
#pragma unroll
            for (int b = 0; b < 2; ++b)
#pragma unroll
                for (int m = 0; m < 4; ++m)
#pragma unroll
                    for (int n = 0; n < 2; ++n) acc[a][b][m][n] = (f32x4){0.f, 0.f, 0.f, 0.f};
        cur = nxt; cA = nA; cB = nB; ++ui;
        if constexpr (ALIGN_EPI) { if (wr == 1) PG8_BAR; }
    }
    PG8_WAIT_V(0);
    if constexpr (!ALIGN_EPI) { if (wr == 0) PG8_BAR; }
    PG8_BAR;
    if constexpr (Epi::AFTER_DRAIN) { E.fused(acc, cur, wr, wc, fr, fq, lds, wid, lane); S.done(cur); }
#undef PG8_SA
#undef PG8_SB
#undef PG8_STAGE
#undef PG8_LDA
#undef PG8_LDB
#undef PG8_MMA
#undef PG8_WAIT_V
#undef PG8_WAIT_L
#undef PG8_BAR
#undef PG8_SCHED
}
}
constexpr int NWAVES = 8, NTHR = 512;
#ifndef MK_N_LAUNCHES
#define MK_N_LAUNCHES 1
#endif
constexpr int N_LAUNCHES = MK_N_LAUNCHES;
constexpr int NPHASE = 12;
constexpr int NB = 2, T = 8192, D = 1024, CTX = 256;
constexpr int MLAT = NB * T, MCTX = NB * CTX, MALL = MLAT + MCTX;
constexpr int NIN = 3968, PP = 4096;
constexpr int C_R = 0, C_K = 512, C_V = 1024, C_LW = 1536, C_LA = 1664, C_LG = 1792, C_RQ = 1920, C_RK = 2432, C_RV = 2944, C_RG = 3456;
constexpr int NCHUNK = 132;
constexpr int RCH = 66;
constexpr int MSLOT = 40960;
constexpr float LN_EPS = 1e-5f, ALPHA = 1.189207115002721f;

constexpr size_t MiB = 1u << 20;
constexpr size_t WS_CTL = 0, CTL_ZERO_BYTES = 1 * MiB;
constexpr size_t WS_MOD = 1 * MiB;
constexpr size_t WS_STATS = WS_MOD + 256 * 1024;
constexpr size_t WS_RT = WS_MOD + 512 * 1024;
constexpr size_t WS_ROPE = WS_MOD + 768 * 1024;
constexpr size_t WS_W2T = 2 * MiB;
constexpr size_t WS_A2T = WS_W2T + 128 * 1024;
constexpr size_t WS_G2T = WS_W2T + 256 * 1024;
constexpr size_t WS_WIN = 3 * MiB;
constexpr size_t WS_WOUT = 11 * MiB;
constexpr size_t WS_ROUTE = 13 * MiB;
constexpr size_t WS_P = 16 * MiB;
constexpr size_t WS_U = 148 * MiB;
constexpr size_t WS_PHIPSI = 148 * MiB;
constexpr size_t WS_HB = 214 * MiB;
constexpr size_t WS_RET = 230 * MiB;
constexpr size_t WS_BV = 263 * MiB;
constexpr size_t WS_GG = 279 * MiB;
constexpr size_t WS_END1 = 295 * MiB;
constexpr size_t WS_WGU = 16 * MiB;
constexpr size_t WS_WD = 80 * MiB;
constexpr size_t WS_U2 = 112 * MiB;
constexpr size_t WS_XS = 144 * MiB;
constexpr size_t WS_HS = 224 * MiB;
constexpr size_t WS_NEED = 295 * MiB;
constexpr int CW_TMO = 0, CW_CNT = 1024  , CW_BAR = 4096;
constexpr size_t RT_TOKE = 0, RT_TOKPOS = 128 * 1024, RT_TOKGATE = 256 * 1024, RT_TOKSLOT = 384 * 1024, RT_SGATE = 512 * 1024;

constexpr int RING_BYTES = 131072;
constexpr int LB = 8192;
constexpr int L_F32A = 14 * LB, L_F32B = L_F32A + 16384, L_MISC = L_F32B + 16384;
constexpr int L_CTL = L_MISC + 4096;
constexpr int LDS_BYTES = 155648;

#define GAS __attribute__((address_space(1)))
#define LAS __attribute__((address_space(3)))
typedef unsigned short bf16;
typedef unsigned v4u __attribute__((ext_vector_type(4)));
typedef float f32x4 __attribute__((ext_vector_type(4)));
typedef GAS unsigned gu32;
#define RLX_AGENT __ATOMIC_RELAXED, __HIP_MEMORY_SCOPE_AGENT
#define LDS_WAIT() asm volatile("s_waitcnt lgkmcnt(0)" ::: "memory")
#define VM_WAIT() asm volatile("s_waitcnt vmcnt(0)" ::: "memory")
__device__ __forceinline__ unsigned f2bf(float f) { unsigned u = __builtin_bit_cast(unsigned, f); return (u + 0x7fffu + ((u >> 16) & 1u)) >> 16; }
__device__ __forceinline__ unsigned pk2(float lo, float hi) { return f2bf(lo) | (f2bf(hi) << 16); }
__device__ __forceinline__ float bf2f(unsigned h) { return __builtin_bit_cast(float, h << 16); }
__device__ __forceinline__ float sigm(float x) { return 1.0f / (1.0f + __expf(-x)); }
__device__ __forceinline__ float wave_sum(float v) {
#pragma unroll
    for (int o = 1; o < 64; o <<= 1) v += __shfl_xor(v, o);
    return v;
}
#define XB_TMO      128
#define XB_XCNT(j)  (256  + 64 * (j))
#define XB_XSUB(j)  (1280 + 64 * (j))
#define XB_XGEN(j)  (2304 + 64 * (j))
#define XB_TOP      3328
#define XB_TOPGEN   3392
#define XCD_BAR_WORDS 3456
#define XB_SPIN_CAP (1u << 18)

__device__ __forceinline__ unsigned xb_ld(unsigned* p)              { return __hip_atomic_load(p, __ATOMIC_RELAXED, __HIP_MEMORY_SCOPE_AGENT); }
__device__ __forceinline__ unsigned xb_add(unsigned* p, unsigned v) { return __hip_atomic_fetch_add(p, v, __ATOMIC_RELAXED, __HIP_MEMORY_SCOPE_AGENT); }
__device__ __forceinline__ unsigned xb_xcc_id() { return (unsigned)__builtin_amdgcn_s_getreg((3 << 11) | 20) & 0xFu; }
#define XB_SPIN(cond, bar) do { unsigned _sp = 0; while (cond) { __builtin_amdgcn_s_sleep(1); \
    if ((++_sp & 255u) == 0u) { if (xb_ld(&(bar)[XB_TMO])) break; if (_sp > XB_SPIN_CAP) { atomicAdd(&(bar)[XB_TMO], 1u); break; } } } } while (0)

struct XcdBarrier {
    unsigned* bar; unsigned x;
    volatile LAS unsigned* st;
};

__device__ __forceinline__ XcdBarrier xcd_barrier_post(unsigned* bar, volatile LAS unsigned* st) {
    XcdBarrier b; b.bar = bar; b.x = xb_xcc_id(); b.st = st;
    if (threadIdx.x == 0) (void)xb_add(&bar[XB_XCNT(b.x)], 1u);
    return b;
}
__device__ __forceinline__ void xcd_barrier_complete(unsigned* bar, unsigned x, unsigned& nloc, unsigned& nx) {
    const unsigned G = gridDim.x * gridDim.y * gridDim.z;
    unsigned sum, cnt, mine, sp = 0u;
    for (;;) {
        sum = 0u; cnt = 0u; mine = 0u;
#pragma unroll
        for (unsigned j = 0; j < 16; ++j) { const unsigned c = xb_ld(&bar[XB_XCNT(j)]); sum += c; cnt += (c > 0u) ? 1u : 0u; mine = (j == x) ? c : mine; }
        if (sum == G) break;
        __builtin_amdgcn_s_sleep(1);
        if ((++sp & 255u) == 0u) { if (xb_ld(&bar[XB_TMO])) break; if (sp > XB_SPIN_CAP) { atomicAdd(&bar[XB_TMO], 1u); break; } }
    }
    nloc = mine > 0u ? mine : 1u; nx = cnt > 0u ? cnt : 1u;
}

__device__ __forceinline__ void xcd_barrier(const XcdBarrier& b) {
    asm volatile("s_waitcnt vmcnt(0)" ::: "memory");
    __syncthreads();
    if (threadIdx.x == 0) {
        unsigned* bar = b.bar;
        __builtin_amdgcn_s_waitcnt(0);
        unsigned nloc = b.st[0], nx = b.st[1];
        if (nloc == 0u) { xcd_barrier_complete(bar, b.x, nloc, nx); b.st[0] = nloc; b.st[1] = nx; }
        const unsigned old = xb_add(&bar[XB_XSUB(b.x)], 1u);
        const unsigned gen = old / nloc;
        if (old + 1u == (gen + 1u) * nloc) {
            __builtin_amdgcn_fence(__ATOMIC_RELEASE, "agent");
            asm volatile("s_waitcnt vmcnt(0)" ::: "memory");
            const unsigned og = xb_add(&bar[XB_TOP], 1u);
            const unsigned tg = og / nx;
            if (og + 1u == (tg + 1u) * nx) xb_add(&bar[XB_TOPGEN], 1u);
            else XB_SPIN(xb_ld(&bar[XB_TOPGEN]) == tg, bar);
            __builtin_amdgcn_fence(__ATOMIC_ACQUIRE, "agent");
            xb_add(&bar[XB_XGEN(b.x)], 1u);
            asm volatile("s_waitcnt vmcnt(0)" ::: "memory");
        } else {
            XB_SPIN(xb_ld(&bar[XB_XGEN(b.x)]) == gen, bar);
            __builtin_amdgcn_fence(__ATOMIC_ACQUIRE, "agent");
            asm volatile("s_waitcnt vmcnt(0)" ::: "memory");
        }
    }
    __syncthreads();
}

struct Args { const float* in[35]; float* out; unsigned char* ws; int ph_lo, ph_hi; };
struct KCtx {
    LAS unsigned char* lds; int tid, lane, wave, vcu, G;
    const Args* a;
};
#define IN_X 0
#define IN_C 1
#define IN_CTX 2
#define IN_CCTX 3
#define IN_EG 4
#define IN_EB 5
#define IN_WMOD 6
#define IN_BMOD 7
#define IN_WIN 8
#define IN_MU 9
#define IN_W0 10
#define IN_W2 11
#define IN_A0 12
#define IN_A2 13
#define IN_G2 14
#define IN_KK 15
#define IN_KA 16
#define IN_RK 17
#define IN_GNG 18
#define IN_GNB 19
#define IN_RDEC 20
#define IN_RGNG 21
#define IN_RGNB 22
#define IN_WOUT 23
#define IN_LN1G 24
#define IN_LN1B 25
#define IN_RG 26
#define IN_RGB 27
#define IN_RE 28
#define IN_REB 29
#define IN_EWG 30
#define IN_EWU 31
#define IN_EWD 32
#define IN_LN2G 33
#define IN_LN2B 34

__device__ __forceinline__ void transpose_item(const float* W, int K, int N, bf16* WT, int row_off, LAS float* scr, int item, int lane) {
    const int nblk = N / 32, kb = item / nblk, nb = item % nblk, k0 = 64 * kb, n0 = 32 * nb;
#pragma unroll 8
    for (int i = 0; i < 32; ++i) { const int kk = 2 * i + (lane >> 5); scr[kk * 33 + (lane & 31)] = W[(size_t)(k0 + kk) * N + n0 + (lane & 31)]; }
    LDS_WAIT(); asm volatile("" ::: "memory");
    const int c = lane & 7;
#pragma unroll
    for (int j = 0; j < 4; ++j) { const int n = (lane >> 3) + 8 * j; const LAS float* s = scr + (8 * c) * 33 + n;
        v4u o; o.x = pk2(s[0 * 33], s[1 * 33]); o.y = pk2(s[2 * 33], s[3 * 33]); o.z = pk2(s[4 * 33], s[5 * 33]); o.w = pk2(s[6 * 33], s[7 * 33]);
        *(GAS v4u*)(WT + (size_t)(row_off + n0 + n) * K + k0 + 8 * c) = o; }
    LDS_WAIT(); asm volatile("" ::: "memory");
}

__device__ __forceinline__ void phase0(const KCtx& X) {
    float* mod = (float*)(X.a->ws + WS_MOD);
    LAS float* sc = (LAS float*)X.lds;
    LAS float* red = sc + 3072;
    const float* wmod = X.a->in[IN_WMOD];
    for (int tile = X.vcu; tile < 192; tile += X.G) {
        for (int i = X.tid; i < 3072; i += NTHR) { const int b = i >> 10, k = i & 1023; const float c = b < 2 ? X.a->in[IN_C][b * 1024 + k] : X.a->in[IN_CCTX][k]; sc[i] = c * sigm(c); }
        __syncthreads();
        const int cq = X.tid & 7, kg = X.tid >> 3; float acc[3][4];
#pragma unroll
        for (int b = 0; b < 3; ++b)
#pragma unroll
            for (int j = 0; j < 4; ++j) acc[b][j] = 0.f;
#pragma unroll 4
        for (int kk = 0; kk < 16; ++kk) { const int k = kg * 16 + kk; const f32x4 w = *(const f32x4*)(wmod + (size_t)k * 6144 + tile * 32 + cq * 4);
#pragma unroll
            for (int b = 0; b < 3; ++b) { const float s = sc[b * 1024 + k];
#pragma unroll
                for (int j = 0; j < 4; ++j) acc[b][j] += s * w[j]; } }
#pragma unroll
        for (int b = 0; b < 3; ++b)
#pragma unroll
            for (int j = 0; j < 4; ++j) red[kg * 96 + cq * 12 + b * 4 + j] = acc[b][j];
        __syncthreads();
        if (X.tid < 96) { float s = 0.f; for (int g = 0; g < 64; ++g) s += red[g * 96 + X.tid];
            const int q = X.tid / 12, b = (X.tid % 12) / 4, j = X.tid & 3, col = tile * 32 + q * 4 + j; mod[b * 6144 + col] = s + X.a->in[IN_BMOD][col]; }
        __syncthreads();
    }
    LAS float* scr = (LAS float*)(X.lds + 40960 + X.wave * 8704);
    const int gw = X.vcu * NWAVES + X.wave, NGW = X.G * NWAVES;
    bf16* WinT = (bf16*)(X.a->ws + WS_WIN); bf16* WoutT = (bf16*)(X.a->ws + WS_WOUT); bf16* W2T = (bf16*)(X.a->ws + WS_W2T); bf16* A2T = (bf16*)(X.a->ws + WS_A2T); bf16* G2T = (bf16*)(X.a->ws + WS_G2T);
    constexpr int I_IN = 16 * 124, I_OUT = 16 * 32, I_L = 16, I_G = 32;
    constexpr int NIT = I_IN + I_OUT + 4 * I_L + I_G;
    for (int it = gw; it < NIT; it += NGW) {
        int r = it;
        if (r < I_IN) { transpose_item(X.a->in[IN_WIN], 1024, NIN, WinT, 0, scr, r, X.lane); continue; } r -= I_IN;
        if (r < I_OUT) { transpose_item(X.a->in[IN_WOUT], 1024, 1024, WoutT, 0, scr, r, X.lane); continue; } r -= I_OUT;
        if (r < I_L) { transpose_item(X.a->in[IN_W2], 64, 512, W2T, 0, scr, r, X.lane); continue; } r -= I_L;
        if (r < I_L) { transpose_item(X.a->in[IN_W2] + 64 * 512, 64, 512, W2T + 512 * 64, 0, scr, r, X.lane); continue; } r -= I_L;
        if (r < I_L) { transpose_item(X.a->in[IN_A2], 64, 512, A2T, 0, scr, r, X.lane); continue; } r -= I_L;
        if (r < I_L) { transpose_item(X.a->in[IN_A2] + 64 * 512, 64, 512, A2T + 512 * 64, 0, scr, r, X.lane); continue; } r -= I_L;
        transpose_item(X.a->in[IN_G2], 128, 512, G2T, 0, scr, r, X.lane);
    }
    const int gt = X.vcu * NTHR + X.tid, NGT = X.G * NTHR;
    for (int i = gt; i < 128 * 1024 / 8; i += NGT) *(GAS v4u*)(WinT + (size_t)NIN * 1024 + (size_t)i * 8) = (v4u){0u, 0u, 0u, 0u};
    float* RTt = (float*)(X.a->ws + WS_RT);
    for (int i = gt; i < 36 * 1024; i += NGT) { const int e = i >> 10, k = i & 1023; RTt[i] = e < 4 ? X.a->in[IN_RG][k * 4 + e] : X.a->in[IN_RE][k * 32 + (e - 4)]; }
    float* rope = (float*)(X.a->ws + WS_ROPE);
    for (int i = gt; i < 128 * 32; i += NGT) { const int pos = i >> 5, f = i & 31; const float inv = exp2f(-(float)f * (13.287712379549449f / 32.0f)); const float ang = (float)pos * inv;
        float rv = ang * 0.15915494309189535f; rv -= rintf(rv); rope[2 * i] = __builtin_amdgcn_cosf(rv); rope[2 * i + 1] = __builtin_amdgcn_sinf(rv); }
}

__device__ __forceinline__ void phase1(const KCtx& X) {
    const float* mod = (const float*)(X.a->ws + WS_MOD); float* stats = (float*)(X.a->ws + WS_STATS); bf16* U = (bf16*)(X.a->ws + WS_U);
    const int gw = X.vcu * NWAVES + X.wave, NGW = X.G * NWAVES;
    for (int m = gw; m < MALL; m += NGW) {
        const float* src = m < MLAT ? X.a->in[IN_X] + (size_t)m * D : X.a->in[IN_CTX] + (size_t)(m - MLAT) * D;
        const float* mr = mod + (m < MLAT ? (m >> 13) : 2) * 6144;
        f32x4 v[4]; float s = 0.f;
#pragma unroll
        for (int j = 0; j < 4; ++j) { v[j] = *(const f32x4*)(src + 4 * X.lane + 256 * j); s += (v[j].x + v[j].y) + (v[j].z + v[j].w); }
        const float mean = wave_sum(s) * (1.f / D); float s2 = 0.f;
#pragma unroll
        for (int j = 0; j < 4; ++j) { v[j] = v[j] - mean; s2 += (v[j].x * v[j].x + v[j].y * v[j].y) + (v[j].z * v[j].z + v[j].w * v[j].w); }
        const float rstd = 1.f / sqrtf(wave_sum(s2) * (1.f / D) + LN_EPS);
        if (X.lane == 0) { stats[2 * m] = mean; stats[2 * m + 1] = rstd; }
#pragma unroll
        for (int j = 0; j < 4; ++j) { const int c = 4 * X.lane + 256 * j;
            const f32x4 g = *(const f32x4*)(X.a->in[IN_EG] + c), bb = *(const f32x4*)(X.a->in[IN_EB] + c), sh = *(const f32x4*)(mr + c), sc = *(const f32x4*)(mr + 1024 + c);
            const f32x4 h = v[j] * rstd * g + bb; const f32x4 u = h * (sc + 1.0f) + sh;
            unsigned long long o = (unsigned long long)pk2(u.x, u.y) | ((unsigned long long)pk2(u.z, u.w) << 32);
            *(unsigned long long*)(U + (size_t)m * D + c) = o; }
    }
}
__device__ __forceinline__ int sw(int r, int c) { return r * 64 + ((((c >> 3) ^ r) & 7) << 3) + (c & 7); }
#define BUF(i) ((LAS bf16*)(X.lds + (i) * LB))
#define MM64(XE, YE, KD, OUT) do { _Pragma("unroll 1") for (int q_ = 0; q_ < 8; ++q_) { const int a = q_ * 8 + X.wave, b = X.lane; float acc = 0.f; \
    _Pragma("unroll 8") for (int k = 0; k < (KD); ++k) acc += (XE) * (YE); OUT; } } while (0)
#define MM64_2(XE1, YE1, XE2, YE2, KD, OUT) do { _Pragma("unroll 1") for (int q_ = 0; q_ < 8; ++q_) { const int a = q_ * 8 + X.wave, b = X.lane; float acc = 0.f; \
    _Pragma("unroll 8") for (int k = 0; k < (KD); ++k) acc += (XE1) * (YE1) - (XE2) * (YE2); OUT; } } while (0)

__device__ __forceinline__ void load_shift8(const bf16* Pb, const float* mu, int b, bool isctx, int t, int c0, float (&o)[8]) {
    const size_t row = isctx ? (size_t)(MLAT + b * CTX + t) : (size_t)(b * T + t);
    const bf16* p = Pb + row * PP + c0;
    const v4u self = *(const v4u*)p;
    v4u n0 = (v4u){0u, 0u, 0u, 0u}, n1 = n0, n2 = n0, n3 = n0;
    if (isctx) { if (t > 0) n0 = *(const v4u*)(p - PP); if (t < CTX - 1) n1 = *(const v4u*)(p + PP); n2 = n0; n3 = n1; }
    else { const int col = t & 63;
        if (col > 0) n0 = *(const v4u*)(p - PP); if (col < 63) n1 = *(const v4u*)(p + PP);
        if (t >= 64) n2 = *(const v4u*)(p - 64 * PP); if (t < T - 64) n3 = *(const v4u*)(p + 64 * PP); }
    const f32x4 m0 = *(const f32x4*)(mu + c0), m1 = *(const f32x4*)(mu + c0 + 4);
    const unsigned sw_[4] = {self.x, self.y, self.z, self.w};
    const unsigned a0[4] = {n0.x, n0.y, n0.z, n0.w}, a1[4] = {n1.x, n1.y, n1.z, n1.w}, a2[4] = {n2.x, n2.y, n2.z, n2.w}, a3[4] = {n3.x, n3.y, n3.z, n3.w};
#pragma unroll
    for (int w = 0; w < 4; ++w) {
        const int j0 = 2 * w, j1 = 2 * w + 1;
        const float p0 = bf2f(sw_[w] & 0xffffu), p1 = bf2f(sw_[w] >> 16);
        const unsigned s0 = ((j0 & 3) == 0) ? a0[w] : a2[w];
        const unsigned s1 = ((j1 & 3) == 1) ? a1[w] : a3[w];
        const float q0 = bf2f(s0 & 0xffffu), q1 = bf2f(s1 >> 16);
        const float mu0 = j0 < 4 ? m0[j0] : m1[j0 - 4], mu1 = j1 < 4 ? m0[j1] : m1[j1 - 4];
        o[j0] = p0 + mu0 * (q0 - p0); o[j1] = p1 + mu1 * (q1 - p1);
    }
}
__device__ __forceinline__ void store8(LAS bf16* buf, int r, int chunk, const float (&v)[8]) {
    v4u o; o.x = pk2(v[0], v[1]); o.y = pk2(v[2], v[3]); o.z = pk2(v[4], v[5]); o.w = pk2(v[6], v[7]);
    *(LAS v4u*)(buf + r * 64 + (((chunk ^ r) & 7) << 3)) = o;
}

template <int DIR> __device__ __forceinline__ void rwkv_solve(const KCtx& X, const LAS float* ABAT, LAS float* Mf, LAS bf16* MM) {
    const int i = X.tid >> 3, sub = X.tid & 7;
#pragma unroll
    for (int q = 0; q < 8; ++q) Mf[i * 65 + 8 * q + sub] = 0.f;
    asm volatile("s_waitcnt lgkmcnt(0)" ::: "memory");
#pragma unroll 1
    for (int tt = 0; tt < 64; ++tt) {
        const int t = DIR ? 63 - tt : tt;
        float p = 0.f;
#pragma unroll
        for (int q = 0; q < 8; ++q) p += Mf[i * 65 + 8 * q + sub] * ABAT[t * 64 + 8 * q + sub];
        p += __shfl_xor(p, 1); p += __shfl_xor(p, 2); p += __shfl_xor(p, 4);
        if (sub == 0) Mf[i * 65 + t] = (i == t ? 1.0f : 0.0f) - p;
        asm volatile("s_waitcnt lgkmcnt(0)" ::: "memory");
    }
#pragma unroll
    for (int q = 0; q < 8; ++q) MM[sw(i, 8 * q + sub)] = (bf16)f2bf(Mf[i * 65 + 8 * q + sub]);
}

template <int DIR> __device__ __forceinline__ void rwkv_dir(const KCtx& X, int b, int h, int blk, bool isctx, int t0) {
    const bf16* Pb = (const bf16*)(X.a->ws + WS_P);
    LAS bf16 *SR = BUF(0), *SK = BUF(1), *SV = BUF(2), *SKK = BUF(3), *TL = BUF(4), *LA = BUF(5), *W2h = BUF(6), *A2h = BUF(7);
    LAS bf16 *AKA = BUF(4), *BKR = BUF(5), *BBR = BUF(6), *MM = BUF(7), *RT = BUF(8), *AT = BUF(9), *KB = BUF(10), *BB = BUF(11), *VA = BUF(12), *PPm = BUF(13), *QQ = BUF(4);
    LAS float* F32A = (LAS float*)(X.lds + L_F32A); LAS float* F32B = (LAS float*)(X.lds + L_F32B);
    LAS float* eL = (LAS float*)(X.lds + L_MISC + 512); LAS float* TOT = eL + 64; LAS float* BON = TOT + 512;
    const int hb = h * 64;
    { const int tok = X.tid >> 3, sub = X.tid & 7; float v[8];
      load_shift8(Pb, X.a->in[IN_MU], b, isctx, t0 + tok, C_LW + DIR * 64 + 8 * sub, v);
#pragma unroll
      for (int j = 0; j < 8; ++j) { const float e = __expf(2.0f * v[j]); v[j] = 1.0f - 2.0f / (e + 1.0f); }
      store8(TL, tok, sub, v);
      load_shift8(Pb, X.a->in[IN_MU], b, isctx, t0 + tok, C_LA + DIR * 64 + 8 * sub, v);
      store8(LA, tok, sub, v);
      const bf16* w2 = (const bf16*)(X.a->ws + WS_W2T) + (size_t)(DIR * 512 + hb + tok) * 64 + 8 * sub;
      const bf16* a2 = (const bf16*)(X.a->ws + WS_A2T) + (size_t)(DIR * 512 + hb + tok) * 64 + 8 * sub;
      *(LAS v4u*)(W2h + tok * 64 + (((sub ^ tok) & 7) << 3)) = *(const v4u*)w2;
      *(LAS v4u*)(A2h + tok * 64 + (((sub ^ tok) & 7) << 3)) = *(const v4u*)a2; }
    __syncthreads();
    { const float w0 = X.a->in[IN_W0][DIR * 512 + hb + X.lane], a0 = X.a->in[IN_A0][DIR * 512 + hb + X.lane];
      MM64(bf2f(TL[sw(a, k)]), bf2f(W2h[sw(b, k)]), 64, F32A[a * 64 + b] = -0.6065306597126334f * sigm(w0 + acc));
      MM64(bf2f(LA[sw(a, k)]), bf2f(A2h[sw(b, k)]), 64, F32B[a * 64 + b] = sigm(a0 + acc)); }
    __syncthreads();
    { const int n = X.lane, g = X.wave; float lw8[8], inc[8]; float run = 0.f;
#pragma unroll
      for (int i = 0; i < 8; ++i) lw8[i] = F32A[(8 * g + i) * 64 + n];
#pragma unroll
      for (int ii = 0; ii < 8; ++ii) { const int i = DIR ? 7 - ii : ii; run += lw8[i]; inc[i] = run; }
      TOT[g * 64 + n] = run;
      __syncthreads();
      float off = 0.f, tot = 0.f;
#pragma unroll
      for (int g2 = 0; g2 < 8; ++g2) { const float tv = TOT[g2 * 64 + n]; tot += tv; if (DIR ? (g2 > g) : (g2 < g)) off += tv; }
      if (g == 0) eL[n] = __expf(tot);
      const float ka = X.a->in[IN_KA][hb + n], rk = X.a->in[IN_RK][hb + n];
#pragma unroll
      for (int i = 0; i < 8; ++i) { const int t = 8 * g + i; const float li = off + inc[i], le = li - lw8[i];
          const float av = F32B[t * 64 + n], r = bf2f(SR[sw(t, n)]), k = bf2f(SK[sw(t, n)]), kk = bf2f(SKK[sw(t, n)]);
          const float kd = k * (1.0f + (av - 1.0f) * ka), ei = __expf(li), en = __expf(-li);
          RT[sw(t, n)] = (bf16)f2bf(r * ei); AT[sw(t, n)] = (bf16)f2bf(kk * __expf(le)); KB[sw(t, n)] = (bf16)f2bf(kd * en); BB[sw(t, n)] = (bf16)f2bf(kk * av * en);
          const float bs = wave_sum(r * kd * rk);
          if (n == 0) { if (DIR == 0) BON[t] = bs; else BON[t] += bs; } } }
    __syncthreads();
    { MM64(bf2f(KB[sw(a, k)]), bf2f(AT[sw(b, k)]), 64, AKA[sw(a, b)] = (bf16)f2bf((DIR ? a > b : a < b) ? acc : 0.f));
      MM64(bf2f(BB[sw(a, k)]), bf2f(AT[sw(b, k)]), 64, F32A[b * 64 + a] = (DIR ? a > b : a < b) ? acc : 0.f);
      MM64(bf2f(KB[sw(a, k)]), bf2f(RT[sw(b, k)]), 64, BKR[sw(a, b)] = (bf16)f2bf((DIR ? a >= b : a <= b) ? acc : 0.f));
      MM64(bf2f(BB[sw(a, k)]), bf2f(RT[sw(b, k)]), 64, BBR[sw(a, b)] = (bf16)f2bf((DIR ? a >= b : a <= b) ? acc : 0.f)); }
    __syncthreads();
    MM64(bf2f(SV[sw(k, a)]), bf2f(AKA[sw(k, b)]), 64, VA[sw(a, b)] = (bf16)f2bf(acc));
    rwkv_solve<DIR>(X, F32A, F32B, MM);
    __syncthreads();
    MM64(bf2f(AT[sw(k, a)]), bf2f(MM[sw(k, b)]), 64, PPm[sw(a, b)] = (bf16)f2bf(acc));
    MM64(bf2f(VA[sw(a, k)]), bf2f(MM[sw(k, b)]), 64, QQ[sw(a, b)] = (bf16)f2bf(acc));
    __syncthreads();
    const int chain = (b * 8 + h) * 2 + DIR;
    const int s = DIR ? (blk < 4 ? 3 - blk : 4 + 127 - (blk - 4)) : blk;
    bf16* PhiT = (bf16*)(X.a->ws + WS_PHIPSI) + ((size_t)chain * NCHUNK + s) * 8192; bf16* Psi = PhiT + 4096;
    MM64(bf2f(BB[sw(k, a)]), bf2f(PPm[sw(b, k)]), 64, PhiT[a * 64 + b] = (bf16)f2bf((a == b ? eL[a] : 0.f) - eL[a] * acc));
    MM64_2(bf2f(SV[sw(k, a)]), bf2f(KB[sw(k, b)]), bf2f(QQ[sw(a, k)]), bf2f(BB[sw(k, b)]), 64, Psi[a * 64 + b] = (bf16)f2bf(eL[b] * acc));
    if (!isctx) {
        const int lb = blk - 4;
        bf16* GT = (bf16*)X.a->out + ((size_t)chain * 128 + lb) * 4096;
        MM64(bf2f(BBR[sw(k, a)]), bf2f(PPm[sw(b, k)]), 64, GT[a * 64 + b] = (bf16)f2bf(bf2f(RT[sw(a, b)]) - acc));
        bf16* Hb = (bf16*)(X.a->ws + WS_HB) + ((size_t)(b * T + t0)) * 512 + hb;
        MM64_2(bf2f(BKR[sw(k, a)]), bf2f(SV[sw(k, b)]), bf2f(BBR[sw(k, a)]), bf2f(QQ[sw(b, k)]), 64,
               { bf16* hp = Hb + (size_t)a * 512 + b; const float prev = DIR ? bf2f(*hp) : 0.f; *hp = (bf16)f2bf(prev + acc); });
    }
    __syncthreads();
}

__device__ __forceinline__ void rwkv_unit(const KCtx& X, int unit) {
    const int blk = unit % NCHUNK, bh = unit / NCHUNK, b = bh >> 3, h = bh & 7;
    const bool isctx = blk < 4; const int t0 = isctx ? blk * 64 : (blk - 4) * 64;
    const bf16* Pb = (const bf16*)(X.a->ws + WS_P);
    LAS bf16 *SR = BUF(0), *SK = BUF(1), *SV = BUF(2), *SKK = BUF(3);
    const int hb = h * 64;
    { const int tok = X.tid >> 3, sub = X.tid & 7; float v[8];
      load_shift8(Pb, X.a->in[IN_MU], b, isctx, t0 + tok, C_R + hb + 8 * sub, v); store8(SR, tok, sub, v);
      load_shift8(Pb, X.a->in[IN_MU], b, isctx, t0 + tok, C_V + hb + 8 * sub, v); store8(SV, tok, sub, v);
      load_shift8(Pb, X.a->in[IN_MU], b, isctx, t0 + tok, C_K + hb + 8 * sub, v); store8(SK, tok, sub, v);
      float ss = 0.f;
#pragma unroll
      for (int j = 0; j < 8; ++j) { v[j] *= X.a->in[IN_KK][hb + 8 * sub + j]; ss += v[j] * v[j]; }
      ss += __shfl_xor(ss, 1); ss += __shfl_xor(ss, 2); ss += __shfl_xor(ss, 4);
      const float inv = 1.0f / fmaxf(sqrtf(ss), 1e-12f);
#pragma unroll
      for (int j = 0; j < 8; ++j) v[j] *= inv;
      store8(SKK, tok, sub, v); }
    __syncthreads();
    rwkv_dir<0>(X, b, h, blk, isctx, t0);
    rwkv_dir<1>(X, b, h, blk, isctx, t0);
    if (!isctx) {
        LAS float* BON = (LAS float*)(X.lds + L_MISC + 512) + 64 + 512;
        LAS bf16* SLG = BUF(4);
        LAS bf16* G2h = BUF(6);
        { const int tok = X.tid >> 3, sub = X.tid & 7; float v[8];
#pragma unroll
          for (int hh = 0; hh < 2; ++hh) { load_shift8(Pb, X.a->in[IN_MU], b, false, t0 + tok, C_LG + 64 * hh + 8 * sub, v);
#pragma unroll
              for (int j = 0; j < 8; ++j) v[j] = sigm(v[j]);
              v4u o; o.x = pk2(v[0], v[1]); o.y = pk2(v[2], v[3]); o.z = pk2(v[4], v[5]); o.w = pk2(v[6], v[7]);
              *(LAS v4u*)(SLG + tok * 128 + 64 * hh + 8 * sub) = o;
              *(LAS v4u*)(G2h + tok * 128 + 64 * hh + 8 * sub) = *(const v4u*)((const bf16*)(X.a->ws + WS_G2T) + (size_t)(hb + tok) * 128 + 64 * hh + 8 * sub); } }
        __syncthreads();
        bf16* BV = (bf16*)(X.a->ws + WS_BV) + ((size_t)(b * T + t0)) * 512 + hb; bf16* GG = (bf16*)(X.a->ws + WS_GG) + ((size_t)(b * T + t0)) * 512 + hb;
        MM64(bf2f(SLG[a * 128 + k]), bf2f(G2h[b * 128 + k]), 128, { GG[(size_t)a * 512 + b] = (bf16)f2bf(acc); BV[(size_t)a * 512 + b] = (bf16)f2bf(BON[a] * bf2f(SV[sw(a, b)])); });
        __syncthreads();
    }
}

__device__ __forceinline__ void rwkv_scan(const KCtx& X, int chain) {
    LAS float* S0 = (LAS float*)X.lds; LAS float* S1 = S0 + 4096; LAS float* PHI = S1 + 4096; LAS float* PSI = PHI + 4096;
    for (int i = X.tid; i < 4096; i += NTHR) S0[i] = 0.f;
    const bf16* PP_ = (const bf16*)(X.a->ws + WS_PHIPSI) + (size_t)chain * NCHUNK * 8192;
    bf16* Sc = (bf16*)X.a->out + 16 * MiB + (size_t)chain * 128 * 4096;
    LAS float* cur = S0; LAS float* nxt = S1;
    for (int s = 0; s < NCHUNK; ++s) {
        const bf16* ph = PP_ + (size_t)s * 8192;
        for (int i = X.tid; i < 4096; i += NTHR) { const int np = i >> 6, n = i & 63; PHI[n * 64 + np] = bf2f(ph[i]); PSI[i] = bf2f(ph[4096 + i]); }
        __syncthreads();
        if (s >= 4) { bf16* sc = Sc + (size_t)(s - 4) * 4096; for (int i = X.tid; i < 4096; i += NTHR) sc[i] = (bf16)f2bf(cur[i]); }
        if (s == NCHUNK - 1) break;
        MM64(cur[a * 64 + k], PHI[k * 64 + b], 64, nxt[a * 64 + b] = acc + PSI[a * 64 + b]);
        __syncthreads();
        LAS float* tmp = cur; cur = nxt; nxt = tmp;
    }
    __syncthreads();
}

__device__ __forceinline__ void rwkv_out_unit(const KCtx& X, int unit) {
    const int lb = unit & 127, bh = unit >> 7, b = bh >> 3, h = bh & 7, hb = h * 64, t0 = lb * 64;
    LAS float* SF = (LAS float*)X.lds; LAS float* SRv = SF + 4096;
    LAS bf16* GF = (LAS bf16*)(SRv + 4096); LAS bf16* GR = GF + 4096;
    const int cf = (b * 8 + h) * 2, cr = cf + 1;
    const bf16* Sc = (const bf16*)X.a->out + 16 * MiB; const bf16* GTb = (const bf16*)X.a->out;
    const bf16* sf = Sc + ((size_t)cf * 128 + lb) * 4096; const bf16* sr = Sc + ((size_t)cr * 128 + (127 - lb)) * 4096;
    const bf16* gf = GTb + ((size_t)cf * 128 + lb) * 4096; const bf16* gr = GTb + ((size_t)cr * 128 + lb) * 4096;
    for (int i = X.tid; i < 4096; i += NTHR) { const int v = i >> 6, n = i & 63; SF[n * 64 + v] = bf2f(sf[i]); SRv[n * 64 + v] = bf2f(sr[i]); GF[i] = gf[i]; GR[i] = gr[i]; }
    __syncthreads();
    const bf16* Hb = (const bf16*)(X.a->ws + WS_HB) + ((size_t)(b * T + t0)) * 512 + hb; const bf16* BV = (const bf16*)(X.a->ws + WS_BV) + ((size_t)(b * T + t0)) * 512 + hb;
    const bf16* GG = (const bf16*)(X.a->ws + WS_GG) + ((size_t)(b * T + t0)) * 512 + hb;
    bf16* O = (bf16*)(X.a->ws + WS_P) + ((size_t)(b * T + t0)) * PP + hb;
    const float gg = X.a->in[IN_GNG][hb + X.lane], gb = X.a->in[IN_GNB][hb + X.lane];
    MM64_2(bf2f(GF[a * 64 + k]), SF[k * 64 + b], -bf2f(GR[a * 64 + k]), SRv[k * 64 + b], 64,
           { const float y = acc + bf2f(Hb[(size_t)a * 512 + b]); const float mean = wave_sum(y) * (1.0f / 64.0f); const float d = y - mean; const float var = wave_sum(d * d) * (1.0f / 64.0f);
             const float o = (d * (1.0f / sqrtf(var + 64e-5f)) * gg + gb + bf2f(BV[(size_t)a * 512 + b])) * bf2f(GG[(size_t)a * 512 + b]);
             O[(size_t)a * PP + b] = (bf16)f2bf(o); });
    __syncthreads();
}
__device__ __forceinline__ float ret_lg(const KCtx& X, int d, int rh) { const float x = X.a->in[IN_RDEC][d * 4 + rh]; return -(x > 20.f ? x : log1pf(__expf(x))); }
__device__ __forceinline__ void ret_load_qk(const KCtx& X, LAS bf16* dst, size_t row0, int colbase, bool rope, int tpos0, float scale, bool transposed) {
    const bf16* Pb = (const bf16*)(X.a->ws + WS_P); const float* rp = (const float*)(X.a->ws + WS_ROPE);
    for (int it = X.tid; it < 1024; it += NTHR) {
        const int j = it >> 3, half = (it >> 2) & 1, pc = it & 3;
        const bf16* p = Pb + (row0 + j) * PP + colbase + half * 64 + pc * 8;
        const v4u a = *(const v4u*)p, b2 = *(const v4u*)(p + 32);
        const unsigned aw[4] = {a.x, a.y, a.z, a.w}, bw[4] = {b2.x, b2.y, b2.z, b2.w};
        float z1[8], z2[8];
#pragma unroll
        for (int w = 0; w < 4; ++w) { z1[2 * w] = bf2f(aw[w] & 0xffffu); z1[2 * w + 1] = bf2f(aw[w] >> 16); z2[2 * w] = bf2f(bw[w] & 0xffffu); z2[2 * w + 1] = bf2f(bw[w] >> 16); }
        float o1[8], o2[8];
        if (rope) { const int tp = tpos0 + j; const int pos = half ? (tp & 63) : (tp >> 6);
#pragma unroll
            for (int e = 0; e < 8; ++e) { const float cs = rp[(pos * 32 + pc * 8 + e) * 2], sn = rp[(pos * 32 + pc * 8 + e) * 2 + 1];
                o1[e] = (z1[e] * cs - z2[e] * sn) * scale; o2[e] = (z1[e] * sn + z2[e] * cs) * scale; } }
        else {
#pragma unroll
            for (int e = 0; e < 8; ++e) { o1[e] = z1[e] * scale; o2[e] = z2[e] * scale; } }
        const int c1 = half * 64 + pc * 8, c2 = c1 + 32;
        if (!transposed) {
            v4u w1, w2; w1.x = pk2(o1[0], o1[1]); w1.y = pk2(o1[2], o1[3]); w1.z = pk2(o1[4], o1[5]); w1.w = pk2(o1[6], o1[7]);
            w2.x = pk2(o2[0], o2[1]); w2.y = pk2(o2[2], o2[3]); w2.z = pk2(o2[4], o2[5]); w2.w = pk2(o2[6], o2[7]);
            *(LAS v4u*)(dst + j * 128 + c1) = w1; *(LAS v4u*)(dst + j * 128 + c2) = w2;
        } else {
#pragma unroll
            for (int e = 0; e < 8; ++e) { dst[(c1 + e) * 128 + j] = (bf16)f2bf(o1[e]); dst[(c2 + e) * 128 + j] = (bf16)f2bf(o2[e]); }
        }
    }
}
__device__ __forceinline__ void ret_load_v(const KCtx& X, LAS bf16* dst, size_t row0, int colbase) {
    const bf16* Pb = (const bf16*)(X.a->ws + WS_P);
    for (int it = X.tid; it < 2048; it += NTHR) { const int j = it >> 4, pc = it & 15; *(LAS v4u*)(dst + j * 128 + pc * 8) = *(const v4u*)(Pb + (row0 + j) * PP + colbase + pc * 8); }
}
__device__ __forceinline__ void ret_u_unit(const KCtx& X, int unit) {
    const int ci = unit % RCH, bh = unit / RCH, b = bh >> 2, rh = bh & 3;
    const bool isctx = ci < 2; const int n = isctx ? ci : ci - 2;
    const size_t row0 = isctx ? (size_t)(MLAT + b * CTX + n * 128) : (size_t)(b * T + n * 128);
    LAS bf16* K = (LAS bf16*)X.lds; LAS bf16* V = K + 16384;
    LAS float* WF = (LAS float*)(X.lds + 65536); LAS float* WR = WF + 128;
    const float lg0 = ret_lg(X, 0, rh), lg1 = ret_lg(X, 1, rh);
    ret_load_qk(X, K, row0, C_RK + rh * 128, !isctx, n * 128, 0.08838834764831845f, false);
    ret_load_v(X, V, row0, C_RV + rh * 128);
    if (X.tid < 128) { WF[X.tid] = __expf(lg0 * (float)(127 - X.tid)); WR[X.tid] = __expf(lg1 * (float)X.tid); }
    __syncthreads();
    const int sf = ci, sr = isctx ? 1 - ci : 2 + 63 - n;
    bf16* Uf = (bf16*)(X.a->ws + WS_RET) + (((size_t)(b * 4 + rh) * 2 + 0) * RCH + sf) * 16384;
    bf16* Ur = (bf16*)(X.a->ws + WS_RET) + (((size_t)(b * 4 + rh) * 2 + 1) * RCH + sr) * 16384;
#pragma unroll 1
    for (int q = 0; q < 16; ++q) { const int dk = q * 8 + X.wave; float af0 = 0.f, af1 = 0.f, ar0 = 0.f, ar1 = 0.f;
#pragma unroll 4
        for (int j = 0; j < 128; ++j) { const float kv = bf2f(K[j * 128 + dk]); const float v0 = bf2f(V[j * 128 + X.lane]), v1 = bf2f(V[j * 128 + 64 + X.lane]);
            const float kf = kv * WF[j], kr = kv * WR[j]; af0 += kf * v0; af1 += kf * v1; ar0 += kr * v0; ar1 += kr * v1; }
        Uf[dk * 128 + X.lane] = (bf16)f2bf(af0); Uf[dk * 128 + 64 + X.lane] = (bf16)f2bf(af1); Ur[dk * 128 + X.lane] = (bf16)f2bf(ar0); Ur[dk * 128 + 64 + X.lane] = (bf16)f2bf(ar1); }
    __syncthreads();
}
__device__ __forceinline__ void ret_prefix(const KCtx& X, int worker, int nworkers) {
    unsigned* R = (unsigned*)(X.a->ws + WS_RET);
    for (int p = worker * NTHR + X.tid; p < 16 * 8192; p += nworkers * NTHR) {
        const int c = p >> 13, e = p & 8191, d = c & 1, rh = (c >> 1) & 3;
        const float g = __expf(ret_lg(X, d, rh) * 128.0f);
        unsigned* q = R + (size_t)c * RCH * 8192 + e; float s0 = 0.f, s1 = 0.f;
#pragma unroll 2
        for (int s = 0; s < RCH; ++s) { const unsigned u = q[(size_t)s * 8192]; q[(size_t)s * 8192] = pk2(s0, s1); s0 = s0 * g + bf2f(u & 0xffffu); s1 = s1 * g + bf2f(u >> 16); }
    }
}
__device__ __forceinline__ void ret_out_unit(const KCtx& X, int unit) {
    const int n = unit & 63, bh = unit >> 6, b = bh >> 2, rh = bh & 3;
    const size_t row0 = (size_t)(b * T + n * 128);
    LAS bf16* Q = (LAS bf16*)X.lds; LAS bf16* KT = Q + 16384; LAS bf16* V = KT + 16384; LAS bf16* SC = V + 16384;
    const float lg0 = ret_lg(X, 0, rh), lg1 = ret_lg(X, 1, rh);
    ret_load_qk(X, Q, row0, C_RQ + rh * 128, true, n * 128, 1.0f, false);
    ret_load_qk(X, KT, row0, C_RK + rh * 128, true, n * 128, 0.08838834764831845f, true);
    ret_load_v(X, V, row0, C_RV + rh * 128);
    __syncthreads();
#pragma unroll 1
    for (int q = 0; q < 16; ++q) { const int i = q * 8 + X.wave; float a0 = 0.f, a1 = 0.f;
#pragma unroll 4
        for (int d = 0; d < 128; ++d) { const float qv = bf2f(Q[i * 128 + d]); a0 += qv * bf2f(KT[d * 128 + X.lane]); a1 += qv * bf2f(KT[d * 128 + 64 + X.lane]); }
        const int j0 = X.lane, j1 = X.lane + 64;
        const float d0 = j0 <= i ? __expf(lg0 * (float)(i - j0)) : __expf(lg1 * (float)(j0 - i)), d1 = j1 <= i ? __expf(lg0 * (float)(i - j1)) : __expf(lg1 * (float)(j1 - i));
        SC[i * 128 + j0] = (bf16)f2bf(a0 * d0); SC[i * 128 + j1] = (bf16)f2bf(a1 * d1); }
    __syncthreads();
    const bf16* Sf = (const bf16*)(X.a->ws + WS_RET) + (((size_t)(b * 4 + rh) * 2 + 0) * RCH + (2 + n)) * 16384;
    const bf16* Sr = (const bf16*)(X.a->ws + WS_RET) + (((size_t)(b * 4 + rh) * 2 + 1) * RCH + (2 + 63 - n)) * 16384;
    const bf16* Pb = (const bf16*)(X.a->ws + WS_P);
    bf16* O = (bf16*)(X.a->ws + WS_P) + row0 * PP + 512 + rh * 128;
    const int c0 = rh * 128 + X.lane, c1 = c0 + 64;
    const float g0 = X.a->in[IN_RGNG][c0], g1 = X.a->in[IN_RGNG][c1], b0 = X.a->in[IN_RGNB][c0], b1 = X.a->in[IN_RGNB][c1];
#pragma unroll 1
    for (int q = 0; q < 16; ++q) { const int i = q * 8 + X.wave; float y0 = 0.f, y1 = 0.f, f0 = 0.f, f1 = 0.f, r0 = 0.f, r1 = 0.f;
#pragma unroll 4
        for (int j = 0; j < 128; ++j) { const float s = bf2f(SC[i * 128 + j]); y0 += s * bf2f(V[j * 128 + X.lane]); y1 += s * bf2f(V[j * 128 + 64 + X.lane]); }
#pragma unroll 4
        for (int d = 0; d < 128; ++d) { const float qv = bf2f(Q[i * 128 + d]);
            f0 += qv * bf2f(Sf[d * 128 + X.lane]); f1 += qv * bf2f(Sf[d * 128 + 64 + X.lane]); r0 += qv * bf2f(Sr[d * 128 + X.lane]); r1 += qv * bf2f(Sr[d * 128 + 64 + X.lane]); }
        const float cf = __expf(lg0 * (float)(i + 1)), cr = __expf(lg1 * (float)(128 - i));
        y0 += cf * f0 + cr * r0; y1 += cf * f1 + cr * r1;
        const float mean = wave_sum(y0 + y1) * (1.0f / 128.0f); const float e0 = y0 - mean, e1 = y1 - mean; const float var = wave_sum(e0 * e0 + e1 * e1) * (1.0f / 128.0f);
        const float rstd = 1.0f / sqrtf(var + 1e-5f);
        const float gt0 = bf2f(Pb[(row0 + i) * PP + C_RG + c0]), gt1 = bf2f(Pb[(row0 + i) * PP + C_RG + c1]);
        O[(size_t)i * PP + X.lane] = (bf16)f2bf((e0 * rstd * g0 + b0) * gt0 * sigm(gt0)); O[(size_t)i * PP + 64 + X.lane] = (bf16)f2bf((e1 * rstd * g1 + b1) * gt1 * sigm(gt1)); }
    __syncthreads();
}
__device__ __forceinline__ void moe_convert(const KCtx& X) {
    LAS float* scr = (LAS float*)(X.lds + X.wave * 8704);
    const int gw = X.vcu * NWAVES + X.wave, NGW = X.G * NWAVES;
    bf16* WguT = (bf16*)(X.a->ws + WS_WGU); bf16* WdT = (bf16*)(X.a->ws + WS_WD);
    constexpr int IGU = 16 * 16, IDN = 8 * 32;
    for (int it = gw; it < 32 * (2 * IGU + IDN); it += NGW) {
        const int e = it / (2 * IGU + IDN); int r = it % (2 * IGU + IDN);
        if (r < 2 * IGU) { const int up = r >= IGU; if (up) r -= IGU; const int nb = r % 16, n0 = nb * 32, pnl = n0 >> 7;
            transpose_item((up ? X.a->in[IN_EWU] : X.a->in[IN_EWG]) + (size_t)e * 1024 * 512, 1024, 512, WguT, e * 1024 + pnl * 128 + up * 128, scr, r, X.lane); }
        else { r -= 2 * IGU; transpose_item(X.a->in[IN_EWD] + (size_t)e * 512 * 1024, 512, 1024, WdT, e * 1024, scr, r, X.lane); }
    }
}
__device__ __forceinline__ void moe_route(const KCtx& X) {
    const float* mod = (const float*)(X.a->ws + WS_MOD); const float* RTt = (const float*)(X.a->ws + WS_RT);
    bf16* U2 = (bf16*)(X.a->ws + WS_U2);
    int* toke = (int*)(X.a->ws + WS_ROUTE + RT_TOKE); int* tokpos = (int*)(X.a->ws + WS_ROUTE + RT_TOKPOS); float* tokgate = (float*)(X.a->ws + WS_ROUTE + RT_TOKGATE);
    unsigned* cnt = (unsigned*)(X.a->ws + WS_CTL) + CW_CNT;
    const int gw = X.vcu * NWAVES + X.wave, NGW = X.G * NWAVES;
    for (int m = gw; m < MLAT; m += NGW) {
        float* zr = X.a->out + (size_t)m * D; const float* mr = mod + (m >> 13) * 6144;
        f32x4 v[4]; float s = 0.f;
#pragma unroll
        for (int j = 0; j < 4; ++j) { v[j] = *(const f32x4*)(zr + 4 * X.lane + 256 * j); s += (v[j].x + v[j].y) + (v[j].z + v[j].w); }
        const float mean = wave_sum(s) * (1.f / D); float s2 = 0.f;
#pragma unroll
        for (int j = 0; j < 4; ++j) { v[j] = v[j] - mean; s2 += (v[j].x * v[j].x + v[j].y * v[j].y) + (v[j].z * v[j].z + v[j].w * v[j].w); }
        const float rstd = 1.f / sqrtf(wave_sum(s2) * (1.f / D) + LN_EPS);
        f32x4 u[4];
#pragma unroll
        for (int j = 0; j < 4; ++j) { const int c = 4 * X.lane + 256 * j;
            const f32x4 g = *(const f32x4*)(X.a->in[IN_LN1G] + c), bb = *(const f32x4*)(X.a->in[IN_LN1B] + c), sh = *(const f32x4*)(mr + 3072 + c), sc = *(const f32x4*)(mr + 4096 + c);
            const f32x4 h = v[j] * rstd * g + bb; *(f32x4*)(zr + c) = h; u[j] = h * (sc + 1.0f) + sh;
            *(unsigned long long*)(U2 + (size_t)m * D + c) = (unsigned long long)pk2(u[j].x, u[j].y) | ((unsigned long long)pk2(u[j].z, u[j].w) << 32); }
        float gl[4]; float gmax = -3.0e38f; int gi = 0;
#pragma unroll
        for (int g = 0; g < 4; ++g) { float p = 0.f;
#pragma unroll
            for (int j = 0; j < 4; ++j) { const f32x4 w = *(const f32x4*)(RTt + g * 1024 + 4 * X.lane + 256 * j); p += (u[j].x * w.x + u[j].y * w.y) + (u[j].z * w.z + u[j].w * w.w); }
            gl[g] = wave_sum(p) + X.a->in[IN_RGB][g]; if (gl[g] > gmax) { gmax = gl[g]; gi = g; } }
        float gsum = 0.f;
#pragma unroll
        for (int g = 0; g < 4; ++g) gsum += __expf(gl[g] - gmax);
        const float gw_ = 1.0f / gsum;
        gi = __builtin_amdgcn_readfirstlane(gi);
        float m1 = -3.0e38f, m2 = -3.0e38f; int i1 = 0, i2 = 0;
        const float* rte = RTt + (size_t)(4 + gi * 8) * 1024;
#pragma unroll 1
        for (int i = 0; i < 8; ++i) { float p = 0.f;
#pragma unroll
            for (int j = 0; j < 4; ++j) { const f32x4 w = *(const f32x4*)(rte + i * 1024 + 4 * X.lane + 256 * j); p += (u[j].x * w.x + u[j].y * w.y) + (u[j].z * w.z + u[j].w * w.w); }
            const float l = wave_sum(p) + X.a->in[IN_REB][gi * 8 + i];
            if (l > m1) { m2 = m1; i2 = i1; m1 = l; i1 = i; } else if (l > m2) { m2 = l; i2 = i; } }
        const float e2 = __expf(m2 - m1); const float ga = gw_ / (1.0f + e2), gb = gw_ * e2 / (1.0f + e2);
        if (X.lane == 0) { const int ea = gi * 8 + i1, eb = gi * 8 + i2;
            const unsigned pa = atomicAdd(cnt + ea, 1u), pb = atomicAdd(cnt + eb, 1u);
            toke[2 * m] = ea; toke[2 * m + 1] = eb; tokpos[2 * m] = (int)pa; tokpos[2 * m + 1] = (int)pb; tokgate[2 * m] = ga; tokgate[2 * m + 1] = gb; }
    }
}
__device__ __forceinline__ int moe_tiles(const KCtx& X, LAS int* tile_e, LAS int* pstart) {
    const unsigned* cnt = (const unsigned*)(X.a->ws + WS_CTL) + CW_CNT;
    if (X.tid == 0) { int acc = 0; for (int e = 0; e < 32; ++e) { const int c = (int)__hip_atomic_load(cnt + e, RLX_AGENT); const int nt = (c + 255) >> 8; pstart[e] = acc * 256; for (int t = 0; t < nt; ++t) tile_e[acc + t] = e; acc += nt; } pstart[32] = acc; }
    __syncthreads();
    return pstart[32];
}
__device__ __forceinline__ void moe_gather(const KCtx& X) {
    LAS int* tile_e = (LAS int*)(X.lds + L_MISC); LAS int* pstart = tile_e + 256;
    (void)moe_tiles(X, tile_e, pstart);
    const bf16* U2 = (const bf16*)(X.a->ws + WS_U2); bf16* Xs = (bf16*)(X.a->ws + WS_XS);
    const int* toke = (const int*)(X.a->ws + WS_ROUTE + RT_TOKE); const int* tokpos = (const int*)(X.a->ws + WS_ROUTE + RT_TOKPOS); const float* tokgate = (const float*)(X.a->ws + WS_ROUTE + RT_TOKGATE);
    int* tokslot = (int*)(X.a->ws + WS_ROUTE + RT_TOKSLOT); float* sgate = (float*)(X.a->ws + WS_ROUTE + RT_SGATE);
    const int gw = X.vcu * NWAVES + X.wave, NGW = X.G * NWAVES;
    for (int m = gw; m < MLAT; m += NGW) {
        const v4u a = *(const v4u*)(U2 + (size_t)m * D + 8 * X.lane), b2 = *(const v4u*)(U2 + (size_t)m * D + 512 + 8 * X.lane);
#pragma unroll
        for (int k = 0; k < 2; ++k) { const int slot = pstart[toke[2 * m + k]] + tokpos[2 * m + k];
            *(v4u*)(Xs + (size_t)slot * D + 8 * X.lane) = a; *(v4u*)(Xs + (size_t)slot * D + 512 + 8 * X.lane) = b2;
            if (X.lane == 0) { tokslot[2 * m + k] = slot; sgate[slot] = tokgate[2 * m + k]; } }
    }
}
__device__ __forceinline__ void moe_final(const KCtx& X) {
    const float* mod = (const float*)(X.a->ws + WS_MOD); const bf16* Ys = (const bf16*)(X.a->ws + WS_XS); const int* tokslot = (const int*)(X.a->ws + WS_ROUTE + RT_TOKSLOT);
    const int gw = X.vcu * NWAVES + X.wave, NGW = X.G * NWAVES;
    for (int m = gw; m < MLAT; m += NGW) {
        float* hr = X.a->out + (size_t)m * D; const float* g2 = mod + (m >> 13) * 6144 + 5120;
        const bf16* y0 = Ys + (size_t)tokslot[2 * m] * D; const bf16* y1 = Ys + (size_t)tokslot[2 * m + 1] * D;
        f32x4 v[4]; float s = 0.f;
#pragma unroll
        for (int j = 0; j < 4; ++j) { const int c = 4 * X.lane + 256 * j; const f32x4 h = *(const f32x4*)(hr + c), gg = *(const f32x4*)(g2 + c);
            const unsigned long long a = *(const unsigned long long*)(y0 + c), b2 = *(const unsigned long long*)(y1 + c);
            f32x4 f; f.x = bf2f((unsigned)a & 0xffffu) + bf2f((unsigned)b2 & 0xffffu); f.y = bf2f(((unsigned)a) >> 16) + bf2f(((unsigned)b2) >> 16);
            f.z = bf2f((unsigned)(a >> 32) & 0xffffu) + bf2f((unsigned)(b2 >> 32) & 0xffffu); f.w = bf2f((unsigned)(a >> 48)) + bf2f((unsigned)(b2 >> 48));
            v[j] = h * ALPHA + gg * f; s += (v[j].x + v[j].y) + (v[j].z + v[j].w); }
        const float mean = wave_sum(s) * (1.f / D); float s2 = 0.f;
#pragma unroll
        for (int j = 0; j < 4; ++j) { v[j] = v[j] - mean; s2 += (v[j].x * v[j].x + v[j].y * v[j].y) + (v[j].z * v[j].z + v[j].w * v[j].w); }
        const float rstd = 1.f / sqrtf(wave_sum(s2) * (1.f / D) + LN_EPS);
#pragma unroll
        for (int j = 0; j < 4; ++j) { const int c = 4 * X.lane + 256 * j; const f32x4 g = *(const f32x4*)(X.a->in[IN_LN2G] + c), bb = *(const f32x4*)(X.a->in[IN_LN2B] + c);
            *(f32x4*)(hr + c) = v[j] * rstd * g + bb; }
    }
}
__global__ void __launch_bounds__(NTHR, 2) fwd_kernel(Args args) {
    extern __shared__ __attribute__((aligned(16))) unsigned char lds_raw[];
    KCtx X;
    X.lds = (LAS unsigned char*)lds_raw;
    X.tid = threadIdx.x; X.lane = X.tid & 63; X.wave = __builtin_amdgcn_readfirstlane(X.tid >> 6);
    X.G = gridDim.x; { const int bx = blockIdx.x; X.vcu = (X.G % 8 == 0) ? (bx % 8) * (X.G / 8) + bx / 8 : bx; }
    X.a = &args;
    volatile LAS unsigned* CTLW = (volatile LAS unsigned*)(X.lds + L_CTL);
    for (int u = X.tid; u < 128; u += NTHR) CTLW[u] = 0u;
    __syncthreads();
    XcdBarrier bar; bar.bar = (unsigned*)(X.a->ws + WS_CTL) + CW_BAR; bar.x = 0; bar.st = nullptr;
    if (N_LAUNCHES == 1) bar = xcd_barrier_post((unsigned*)(X.a->ws + WS_CTL) + CW_BAR, CTLW + 8);
    const int lo = args.ph_lo, hi = args.ph_hi;
#ifndef PHMASK
#define PHMASK 0xFFF
#endif
#define IN(k) (((PHMASK >> (k)) & 1) && lo <= (k) && (k) < hi)
#define SEAM(k) do { if (IN(k) && IN((k) + 1)) xcd_barrier(bar); } while (0)

    if (IN(0)) { phase0(X); } SEAM(0);
    if (IN(1)) { phase1(X); } SEAM(1);
    if (IN(2)) {
        pg8::Gemm g{(const bf16*)(X.a->ws + WS_U), (const bf16*)(X.a->ws + WS_WIN), MALL, PP, D, D}; pg8::StaticOrder S; S.init(MALL, PP, X.G, (int)blockIdx.x);
        pg8::EpiBf16 E{(bf16*)(X.a->ws + WS_P), PP};
        pg8::gemm_phase<pg8::EpiBf16, pg8::StaticOrder, true, true>(X.lds, g, S, E);
    } SEAM(2);
    if (IN(3)) {
        for (int u = X.vcu; u < 16 * NCHUNK + 8 * RCH; u += X.G) { if (u < 16 * NCHUNK) rwkv_unit(X, u); else ret_u_unit(X, u - 16 * NCHUNK); }
    } SEAM(3);
    if (IN(4)) {
        if (X.G >= 64) { if (X.vcu < 32) rwkv_scan(X, X.vcu); else ret_prefix(X, X.vcu - 32, X.G - 32); }
        else { for (int c = X.vcu; c < 32; c += X.G) rwkv_scan(X, c); ret_prefix(X, X.vcu, X.G); }
    } SEAM(4);
    if (IN(5)) {
        for (int u = X.vcu; u < 2048 + 512; u += X.G) { if (u < 512) ret_out_unit(X, u); else rwkv_out_unit(X, u - 512); }
    } SEAM(5);
    if (IN(6)) {
        pg8::Gemm g{(const bf16*)(X.a->ws + WS_P), (const bf16*)(X.a->ws + WS_WOUT), MLAT, D, D, PP}; pg8::StaticOrder S; S.init(MLAT, D, X.G, (int)blockIdx.x);
        pg8::EpiOut E{X.a->in[IN_X], (const float*)(X.a->ws + WS_STATS), X.a->in[IN_EG], X.a->in[IN_EB], (const float*)(X.a->ws + WS_MOD), X.a->out, ALPHA};
        pg8::gemm_phase<pg8::EpiOut, pg8::StaticOrder, true, true>(X.lds, g, S, E);
    } SEAM(6);
    if (IN(7)) { moe_convert(X); moe_route(X); } SEAM(7);
    if (IN(8)) { moe_gather(X); } SEAM(8);
    if (IN(9)) {
        LAS int* tile_e = (LAS int*)(X.lds + L_MISC); LAS int* pstart = tile_e + 256;
        const int ntiles = moe_tiles(X, tile_e, pstart);
        pg8::Gemm g{(const bf16*)(X.a->ws + WS_XS), (const bf16*)(X.a->ws + WS_WGU), ntiles * 256, 1024, D, D};
        pg8::MoeOrder S; S.base.init(ntiles * 256, 1024, X.G, (int)blockIdx.x); S.tile_e = tile_e;
        pg8::EpiGU E{(bf16*)(X.a->ws + WS_HS)};
        pg8::gemm_phase<pg8::EpiGU, pg8::MoeOrder, true, true>(X.lds, g, S, E);
    } SEAM(9);
    if (IN(10)) {
        LAS int* tile_e = (LAS int*)(X.lds + L_MISC); LAS int* pstart = tile_e + 256;
        const int ntiles = moe_tiles(X, tile_e, pstart);
        pg8::Gemm g{(const bf16*)(X.a->ws + WS_HS), (const bf16*)(X.a->ws + WS_WD), ntiles * 256, 1024, 512, 512};
        pg8::MoeOrder S; S.base.init(ntiles * 256, 1024, X.G, (int)blockIdx.x); S.tile_e = tile_e;
        pg8::EpiDown E{(bf16*)(X.a->ws + WS_XS), (const float*)(X.a->ws + WS_ROUTE + RT_SGATE)};
        pg8::gemm_phase<pg8::EpiDown, pg8::MoeOrder, true, true>(X.lds, g, S, E);
    } SEAM(10);
    if (IN(11)) { moe_final(X); }
#undef IN
#undef SEAM
}

extern "C" void kernel_launch(void* const* d_in, const int* in_sizes, int n_in, void* d_out, int out_size, void* d_ws, size_t ws_size, hipStream_t stream) {
    static int grid = 0;
    if (grid == 0) {
        if (n_in != 35 || out_size != MLAT * D || ws_size < WS_NEED) { fprintf(stderr, "kernel_launch: unexpected problem (n_in %d, out %d, ws %zu < %zu)\n", n_in, out_size, ws_size, (size_t)WS_NEED); grid = -1; return; }
        int dev = 0, cus = 0;
        if (hipGetDevice(&dev) != hipSuccess || hipDeviceGetAttribute(&cus, hipDeviceAttributeMultiprocessorCount, dev) != hipSuccess) { grid = -1; return; }
        if (hipFuncSetAttribute((const void*)fwd_kernel, hipFuncAttributeMaxDynamicSharedMemorySize, LDS_BYTES) != hipSuccess) { fprintf(stderr, "kernel_launch: hipFuncSetAttribute failed\n"); grid = -1; return; }
        (void)hipGetLastError();
        grid = cus;
    }
    if (grid < 0) return;
    if (hipMemsetAsync((char*)d_ws + WS_CTL, 0, CTL_ZERO_BYTES, stream) != hipSuccess) return;
    Args a{};
    for (int i = 0; i < 35; ++i) a.in[i] = (const float*)d_in[i];
    a.out = (float*)d_out; a.ws = (unsigned char*)d_ws;
    if (N_LAUNCHES == 1) { a.ph_lo = 0; a.ph_hi = NPHASE; hipLaunchKernelGGL(fwd_kernel, dim3(grid), dim3(NTHR), LDS_BYTES, stream, a); }
    else for (int p = 0; p < NPHASE; ++p) { a.ph_lo = p; a.ph_hi = p + 1; hipLaunchKernelGGL(fwd_kernel, dim3(grid), dim3(NTHR), LDS_BYTES, stream, a); }
}
```

```cpp
#include <hip/hip_runtime.h>
#include <cstdio>
#include <cstdint>
namespace pg8 {
#define PG8_LAS __attribute__((address_space(3)))
typedef unsigned short bf16_t;
typedef short bf16x8 __attribute__((ext_vector_type(8)));
typedef float f32x4 __attribute__((ext_vector_type(4)));
typedef unsigned u32x4 __attribute__((ext_vector_type(4)));
constexpr int BM = 256, BK = 64, HALF = 128, HTB = HALF * BK * 2  , STAGE_BYTES = 8 * HTB, NXCD = 8, WGM = 8;

__host__ __device__ __forceinline__ int lds_byte(int r, int c) { const int st = (r >> 4) * 2 + (c >> 5), rr = r & 15, cc = c & 31, ob = rr * 64 + cc * 2; return st * 1024 + (ob ^ (((ob >> 9) & 1) << 5)); }
__host__ __device__ __forceinline__ void stage_rc(int b, int& R, int& C) { const int st = b / 1024, sb = b % 1024, swz = sb ^ (((sb >> 9) & 1) << 5); R = (st >> 1) * 16 + swz / 64; C = (st & 1) * 32 + (swz % 64) / 2; }
__host__ __device__ __forceinline__ int perm32(int rho) { const int n = rho >> 4, i = rho & 15; return 8 * (i >> 2) + 4 * n + (i & 3); }

struct Unit { int pm, pn; };
struct Gemm { const bf16_t* A; const bf16_t* Bt; int M, N, K, lda; };

struct StaticOrder {
    int nM, nN, nwg, G, c;
    __host__ __device__ void init(int M, int N, int G_, int c_) { nM = M / BM; nN = N / BM; nwg = nM * nN; G = G_; c = c_; }
    __host__ __device__ bool next(int i, Unit& u) const {
        const long L = (long)i * G + c; if (L >= nwg) return false;
        int wgid = (int)L; { const int q = nwg / NXCD, r = nwg % NXCD, xcd = wgid % NXCD, off = wgid / NXCD; wgid = (xcd < r ? xcd * (q + 1) : r * (q + 1) + (xcd - r) * q) + off; }
        const int nig = WGM * nN, gid = wgid / nig, fm = gid * WGM, gsz = (nM - fm) < WGM ? (nM - fm) : WGM;
        u.pm = fm + ((wgid % nig) % gsz); u.pn = (wgid % nig) / gsz; return true;
    }
    __device__ __forceinline__ void a_ready(const Unit&) const {}
    __device__ __forceinline__ void done(const Unit&) const {}
};

__device__ __forceinline__ unsigned cvt_pk_bf16(float lo, float hi) { unsigned r; asm volatile("v_cvt_pk_bf16_f32 %0, %1, %2" : "=v"(r) : "v"(lo), "v"(hi)); return r; }
typedef float f32x2 __attribute__((ext_vector_type(2)));
struct EpiBf16 {
    static constexpr bool PERM = true, AFTER_DRAIN = false;
    bf16_t* O; int ldc;
    __device__ __forceinline__ void operator()(const f32x4 (&acc)[2][2][4][2], const Unit& u, int wr, int wc, int fr, int fq) const {
        const int row0 = u.pm * BM + wr * 64 + fr; const int col0 = u.pn * BM + wc * 32 + 8 * fq;
#pragma unroll
        for (int ai = 0; ai < 2; ++ai)
#pragma unroll
            for (int m = 0; m < 4; ++m) { bf16_t* rowp = O + (size_t)(row0 + ai * HALF + m * 16) * ldc + col0;
#pragma unroll
                for (int bj = 0; bj < 2; ++bj) { const f32x4 v0 = acc[ai][bj][m][0], v1 = acc[ai][bj][m][1];
                    u32x4 w; w.x = cvt_pk_bf16(v0[0], v0[1]); w.y = cvt_pk_bf16(v0[2], v0[3]); w.z = cvt_pk_bf16(v1[0], v1[1]); w.w = cvt_pk_bf16(v1[2], v1[3]);
                    *(u32x4*)(rowp + bj * HALF) = w; } }
    }
};
struct EpiOut {
    static constexpr bool PERM = false, AFTER_DRAIN = false;
    const float* x; const float* stats; const float* eg; const float* eb; const float* mod; float* Z; float alpha;
    __device__ __forceinline__ void operator()(const f32x4 (&acc)[2][2][4][2], const Unit& u, int wr, int wc, int fr, int fq) const {
        const int col0 = u.pn * BM + wc * 32 + 4 * fq;
        const int b = (u.pm * BM) >> 13;
        const float* g1 = mod + (size_t)b * 6144 + 2048;
#pragma unroll
        for (int bj = 0; bj < 2; ++bj)
#pragma unroll
            for (int n = 0; n < 2; ++n) { const int c = col0 + bj * HALF + n * 16;
                const f32x4 vg = *(const f32x4*)(eg + c), vb = *(const f32x4*)(eb + c), v1 = *(const f32x4*)(g1 + c);
#pragma unroll
                for (int ai = 0; ai < 2; ++ai)
#pragma unroll
                    for (int m = 0; m < 4; ++m) { const int r = u.pm * BM + ai * HALF + wr * 64 + m * 16 + fr;
                        const float mean = stats[2 * r], rstd = stats[2 * r + 1];
                        const f32x4 xv = *(const f32x4*)(x + (size_t)r * 1024 + c);
                        f32x4 o = ((xv - mean) * rstd * vg + vb) * alpha + v1 * acc[ai][bj][m][n];
                        *(f32x4*)(Z + (size_t)r * 1024 + c) = o; } }
    }
};
struct EpiGU {
    static constexpr bool PERM = true, AFTER_DRAIN = false;
    bf16_t* Hs;
    __device__ __forceinline__ void operator()(const f32x4 (&acc)[2][2][4][2], const Unit& u, int wr, int wc, int fr, int fq) const {
        const int row0 = u.pm * BM + wr * 64 + fr; const int col0 = (u.pn & 3) * 128 + wc * 32 + 8 * fq;
#pragma unroll
        for (int ai = 0; ai < 2; ++ai)
#pragma unroll
            for (int m = 0; m < 4; ++m) { bf16_t* rowp = Hs + (size_t)(row0 + ai * HALF + m * 16) * 512 + col0;
                float h[8];
#pragma unroll
                for (int n = 0; n < 2; ++n)
#pragma unroll
                    for (int j = 0; j < 4; ++j) { const float g = acc[ai][0][m][n][j], up = acc[ai][1][m][n][j]; h[n * 4 + j] = g / (1.0f + __expf(-g)) * up; }
                u32x4 w; w.x = cvt_pk_bf16(h[0], h[1]); w.y = cvt_pk_bf16(h[2], h[3]); w.z = cvt_pk_bf16(h[4], h[5]); w.w = cvt_pk_bf16(h[6], h[7]);
                *(u32x4*)rowp = w; }
    }
};
struct EpiDown {
    static constexpr bool PERM = true, AFTER_DRAIN = false;
    bf16_t* Ys; const float* sgate;
    __device__ __forceinline__ void operator()(const f32x4 (&acc)[2][2][4][2], const Unit& u, int wr, int wc, int fr, int fq) const {
        const int row0 = u.pm * BM + wr * 64 + fr; const int col0 = (u.pn & 3) * 256 + wc * 32 + 8 * fq;
#pragma unroll
        for (int ai = 0; ai < 2; ++ai)
#pragma unroll
            for (int m = 0; m < 4; ++m) { const int r = row0 + ai * HALF + m * 16; const float gt = sgate[r]; bf16_t* rowp = Ys + (size_t)r * 1024 + col0;
#pragma unroll
                for (int bj = 0; bj < 2; ++bj) { const f32x4 v0 = acc[ai][bj][m][0] * gt, v1 = acc[ai][bj][m][1] * gt;
                    u32x4 w; w.x = cvt_pk_bf16(v0[0], v0[1]); w.y = cvt_pk_bf16(v0[2], v0[3]); w.z = cvt_pk_bf16(v1[0], v1[1]); w.w = cvt_pk_bf16(v1[2], v1[3]);
                    *(u32x4*)(rowp + bj * HALF) = w; } }
    }
};
struct MoeOrder {
    StaticOrder base; const PG8_LAS int* tile_e;
    __device__ __forceinline__ bool next(int i, Unit& u) const { if (!base.next(i, u)) return false; u.pn += 4 * tile_e[u.pm]; return true; }
    __device__ __forceinline__ void a_ready(const Unit&) const {}
    __device__ __forceinline__ void done(const Unit&) const {}
};
template <class Epi, class Sched, bool ALIGN_EPI = false, bool SP2 = false>
__device__ __forceinline__ void gemm_phase(PG8_LAS unsigned char* lds, const Gemm g, const Sched& S, const Epi& E) {
    const int tid = threadIdx.x, wid = __builtin_amdgcn_readfirstlane(tid >> 6), lane = tid & 63, wr = wid >> 2, wc = wid & 3, fr = lane & 15, fq = lane >> 4;
    const int K = g.K, nt = K / BK;
    unsigned voffA[2], voffB[2];
#pragma unroll
    for (int i = 0; i < 2; ++i) { int R, C; stage_rc(tid * 16 + i * 8192, R, C); const int Rb = Epi::PERM ? ((R & ~31) + perm32(R & 31)) : R;
        voffA[i] = (unsigned)(R * g.lda + C) * 2u; voffB[i] = (unsigned)(Rb * K + C) * 2u; }
    const size_t kstep = (size_t)(BK * 2);
    const size_t hstep = (size_t)HALF * K * 2;
    const size_t tstep = 2 * hstep; const size_t hstepA = (size_t)HALF * g.lda * 2, tstepA = 2 * hstepA;
    const unsigned ldsw = (unsigned)wid * 1024u;
    const int aoff = lds_byte(wr * 64 + fr, fq * 8), boff = lds_byte(wc * 32 + fr, fq * 8);
#define PG8_SA(b, h) (((b) * 2 + (h)) * HTB)
#define PG8_SB(b, h) ((4 + (b) * 2 + (h)) * HTB)
#define PG8_STAGE(bufoff, gbase, voff) do { _Pragma("unroll") for (int _i = 0; _i < 2; ++_i) \
        __builtin_amdgcn_global_load_lds((const unsigned*)((const char*)(gbase) + (voff)[_i]), (PG8_LAS unsigned*)(lds + (bufoff) + ldsw + _i * 8192), 16, 0, 0); } while (0)
#define PG8_LDA(dst, b, h) do { _Pragma("unroll") for (int m = 0; m < 4; ++m) _Pragma("unroll") for (int k = 0; k < 2; ++k) dst[m][k] = *(const PG8_LAS bf16x8*)(lds + PG8_SA(b, h) + aoff + m * 2048 + k * 1024); } while (0)
#define PG8_LDB(dst, b, h) do { _Pragma("unroll") for (int n = 0; n < 2; ++n) _Pragma("unroll") for (int k = 0; k < 2; ++k) dst[n][k] = *(const PG8_LAS bf16x8*)(lds + PG8_SB(b, h) + boff + n * 2048 + k * 1024); } while (0)
#define PG8_MMA(ai, bj, At, Bt) do { __builtin_amdgcn_s_setprio(1); _Pragma("unroll") for (int m = 0; m < 4; ++m) _Pragma("unroll") for (int n = 0; n < 2; ++n) _Pragma("unroll") for (int k = 0; k < 2; ++k) \
        acc[ai][bj][m][n] = __builtin_amdgcn_mfma_f32_16x16x32_bf16(Bt[n][k], At[m][k], acc[ai][bj][m][n], 0, 0, 0); __builtin_amdgcn_s_setprio(0); } while (0)
#define PG8_WAIT_V(n) asm volatile("s_waitcnt vmcnt(" #n ")" ::: "memory")
#define PG8_WAIT_L(n) asm volatile("s_waitcnt lgkmcnt(" #n ")" ::: "memory")
#define PG8_BAR __builtin_amdgcn_s_barrier()
#define PG8_SCHED __builtin_amdgcn_sched_barrier(0)
    Unit cur, nxt; int ui = 0;
    if (!S.next(0, cur)) return;
    f32x4 acc[2][2][4][2];
#pragma unroll
    for (int a = 0; a < 2; ++a)
#pragma unroll
        for (int b = 0; b < 2; ++b)
#pragma unroll
            for (int m = 0; m < 4; ++m)
#pragma unroll
                for (int n = 0; n < 2; ++n) acc[a][b][m][n] = (f32x4){0.f, 0.f, 0.f, 0.f};
    bf16x8 At[4][2], B0[2][2], B1[2][2];
    const char* cA = (const char*)g.A + (size_t)cur.pm * tstepA; const char* cB = (const char*)g.Bt + (size_t)cur.pn * tstep;
    S.a_ready(cur);
    if constexpr (SP2) {
        PG8_STAGE(PG8_SB(0, 0), cB, voffB); PG8_STAGE(PG8_SB(0, 1), cB + hstep, voffB); PG8_STAGE(PG8_SA(0, 0), cA, voffA); PG8_STAGE(PG8_SA(0, 1), cA + hstepA, voffA);
        if (wr == 1) PG8_BAR;
        PG8_WAIT_V(2); PG8_BAR;
        PG8_STAGE(PG8_SB(1, 0), cB + kstep, voffB); PG8_STAGE(PG8_SA(1, 0), cA + kstep, voffA); PG8_STAGE(PG8_SB(1, 1), cB + hstep + kstep, voffB);
        PG8_WAIT_V(6); PG8_BAR;
    } else {
        PG8_STAGE(PG8_SB(0, 0), cB, voffB); PG8_STAGE(PG8_SA(0, 0), cA, voffA); PG8_STAGE(PG8_SB(0, 1), cB + hstep, voffB); PG8_STAGE(PG8_SA(0, 1), cA + hstepA, voffA);
        if (wr == 1) PG8_BAR;
        PG8_WAIT_V(4); PG8_BAR;
        PG8_STAGE(PG8_SB(1, 0), cB + kstep, voffB); PG8_STAGE(PG8_SA(1, 0), cA + kstep, voffA); PG8_STAGE(PG8_SB(1, 1), cB + hstep + kstep, voffB);
        PG8_WAIT_V(6); PG8_BAR;
    }
    for (;;) {
        const bool has_next = S.next(ui + 1, nxt);
        const char* nA = has_next ? (const char*)g.A + (size_t)nxt.pm * tstepA : cA; const char* nB = has_next ? (const char*)g.Bt + (size_t)nxt.pn * tstep : cB;
        for (int t = 0; t < nt; t += 2) {
            const bool last = (t == nt - 2);
            const char* a1 = cA + (size_t)(t + 1) * kstep;
            const char* a2 = last ? nA : cA + (size_t)(t + 2) * kstep; const char* b2 = last ? nB : cB + (size_t)(t + 2) * kstep;
            const char* a3 = a2 + kstep; const char* b3 = b2 + kstep;
            if (last && has_next) S.a_ready(nxt);
            if constexpr (SP2) {
            PG8_LDB(B0, 0, 0); PG8_LDB(B1, 0, 1); PG8_SCHED; PG8_LDA(At, 0, 0); PG8_STAGE(PG8_SA(1, 1), a1 + hstepA, voffA);
            PG8_WAIT_V(8); PG8_WAIT_L(0); PG8_BAR; PG8_MMA(0, 0, At, B0); PG8_MMA(0, 1, At, B1); PG8_BAR; PG8_SCHED;
            PG8_LDA(At, 0, 1); PG8_STAGE(PG8_SB(0, 0), b2, voffB); PG8_STAGE(PG8_SB(0, 1), b2 + hstep, voffB); PG8_STAGE(PG8_SA(0, 0), a2, voffA);
            PG8_WAIT_V(8); PG8_WAIT_L(0); PG8_BAR; PG8_MMA(1, 0, At, B0); PG8_MMA(1, 1, At, B1); PG8_BAR; PG8_SCHED;
            PG8_LDB(B0, 1, 0); PG8_LDB(B1, 1, 1); PG8_SCHED; PG8_LDA(At, 1, 0); PG8_STAGE(PG8_SA(0, 1), a2 + hstepA, voffA);
            PG8_WAIT_V(8); PG8_WAIT_L(0); PG8_BAR; PG8_MMA(0, 0, At, B0); PG8_MMA(0, 1, At, B1); PG8_BAR; PG8_SCHED;
            PG8_LDA(At, 1, 1); PG8_STAGE(PG8_SB(1, 0), b3, voffB); PG8_STAGE(PG8_SB(1, 1), b3 + hstep, voffB); PG8_STAGE(PG8_SA(1, 0), a3, voffA);
            PG8_WAIT_V(8); PG8_WAIT_L(0); PG8_BAR; PG8_MMA(1, 0, At, B0); PG8_MMA(1, 1, At, B1); PG8_BAR; PG8_SCHED;
            } else {
            PG8_LDB(B0, 0, 0); PG8_SCHED; PG8_LDA(At, 0, 0); PG8_STAGE(PG8_SA(1, 1), a1 + hstepA, voffA);
            PG8_WAIT_L(8); PG8_BAR; PG8_WAIT_L(0); PG8_MMA(0, 0, At, B0); PG8_BAR; PG8_SCHED;
            PG8_LDB(B1, 0, 1); PG8_STAGE(PG8_SB(0, 0), b2, voffB);
            PG8_BAR; PG8_WAIT_L(0); PG8_MMA(0, 1, At, B1); PG8_BAR;
            PG8_LDA(At, 0, 1); PG8_STAGE(PG8_SA(0, 0), a2, voffA);
            PG8_BAR; PG8_WAIT_L(0); PG8_MMA(1, 0, At, B0); PG8_BAR; PG8_SCHED;
            PG8_STAGE(PG8_SB(0, 1), b2 + hstep, voffB);
            PG8_WAIT_V(6); PG8_BAR; PG8_MMA(1, 1, At, B1); PG8_BAR;
            PG8_LDB(B0, 1, 0); PG8_SCHED; PG8_LDA(At, 1, 0); PG8_STAGE(PG8_SA(0, 1), a2 + hstepA, voffA);
            PG8_WAIT_L(8); PG8_BAR; PG8_WAIT_L(0); PG8_MMA(0, 0, At, B0); PG8_BAR; PG8_SCHED;
            PG8_LDB(B1, 1, 1); PG8_STAGE(PG8_SB(1, 0), b3, voffB);
            PG8_BAR; PG8_WAIT_L(0); PG8_MMA(0, 1, At, B1); PG8_BAR;
            PG8_LDA(At, 1, 1); PG8_STAGE(PG8_SA(1, 0), a3, voffA);
            PG8_BAR; PG8_WAIT_L(0); PG8_MMA(1, 0, At, B0); PG8_BAR; PG8_SCHED;
            PG8_STAGE(PG8_SB(1, 1), b3 + hstep, voffB);
            PG8_WAIT_V(6); PG8_BAR; PG8_MMA(1, 1, At, B1); PG8_BAR;
            }
        }
        if constexpr (ALIGN_EPI) { if (wr == 0) PG8_BAR; }
        if constexpr (!Epi::AFTER_DRAIN) { E(acc, cur, wr, wc, fr, fq); S.done(cur); }
        if (!has_next) break;
#pragma unroll
        for (int a = 0; a < 2; ++a)
#pragma unroll
            for (int b = 0; b < 2; ++b)
#pragma unroll
                for (int m = 0; m < 4; ++m)
#pragma unroll
                    for (int n = 0; n < 2; ++n) acc[a][b][m][n] = (f32x4){0.f, 0.f, 0.f, 0.f};
        cur = nxt; cA = nA; cB = nB; ++ui;
        if constexpr (ALIGN_EPI) { if (wr == 1) PG8_BAR; }
    }
    PG8_WAIT_V(0);
    if constexpr (!ALIGN_EPI) { if (wr == 0) PG8_BAR; }
    PG8_BAR;
    if constexpr (Epi::AFTER_DRAIN) { E.fused(acc, cur, wr, wc, fr, fq, lds, wid, lane); S.done(cur); }
#undef PG8_SA
#undef PG8_SB
#undef PG8_STAGE
#undef PG8_LDA
#undef PG8_LDB
#undef PG8_MMA
#undef PG8_WAIT_V
#undef PG8_WAIT_L
#undef PG8_BAR
#undef PG8_SCHED
}
}
constexpr int NWAVES = 8, NTHR = 512;
#ifndef MK_N_LAUNCHES
#define MK_N_LAUNCHES 1
#endif
constexpr int N_LAUNCHES = MK_N_LAUNCHES;
constexpr int NPHASE = 12;
constexpr int NB = 2, T = 8192, D = 1024, CTX = 256;
constexpr int MLAT = NB * T, MCTX = NB * CTX, MALL = MLAT + MCTX;
constexpr int NIN = 3968, PP = 4096;
constexpr int C_R = 0, C_K = 512, C_V = 1024, C_LW = 1536, C_LA = 1664, C_LG = 1792, C_RQ = 1920, C_RK = 2432, C_RV = 2944, C_RG = 3456;
constexpr int NCHUNK = 132;
constexpr int RCH = 66;
constexpr int MSLOT = 40960;
constexpr float LN_EPS = 1e-5f, ALPHA = 1.189207115002721f;

constexpr size_t MiB = 1u << 20;
constexpr size_t WS_CTL = 0, CTL_ZERO_BYTES = 1 * MiB;
constexpr size_t WS_MOD = 1 * MiB;
constexpr size_t WS_STATS = WS_MOD + 256 * 1024;
constexpr size_t WS_RT = WS_MOD + 512 * 1024;
constexpr size_t WS_ROPE = WS_MOD + 768 * 1024;
constexpr size_t WS_W2T = 2 * MiB;
constexpr size_t WS_A2T = WS_W2T + 128 * 1024;
constexpr size_t WS_G2T = WS_W2T + 256 * 1024;
constexpr size_t WS_WIN = 3 * MiB;
constexpr size_t WS_WOUT = 11 * MiB;
constexpr size_t WS_ROUTE = 13 * MiB;
constexpr size_t WS_P = 16 * MiB;
constexpr size_t WS_U = 148 * MiB;
constexpr size_t WS_PHIPSI = 148 * MiB;
constexpr size_t WS_HB = 214 * MiB;
constexpr size_t WS_RET = 230 * MiB;
constexpr size_t WS_BV = 263 * MiB;
constexpr size_t WS_GG = 279 * MiB;
constexpr size_t WS_END1 = 295 * MiB;
constexpr size_t WS_WGU = 16 * MiB;
constexpr size_t WS_WD = 80 * MiB;
constexpr size_t WS_U2 = 112 * MiB;
constexpr size_t WS_XS = 144 * MiB;
constexpr size_t WS_HS = 224 * MiB;
constexpr size_t WS_NEED = 295 * MiB;
constexpr int CW_TMO = 0, CW_CNT = 1024  , CW_BAR = 4096;
constexpr size_t RT_TOKE = 0, RT_TOKPOS = 128 * 1024, RT_TOKGATE = 256 * 1024, RT_TOKSLOT = 384 * 1024, RT_SGATE = 512 * 1024;

constexpr int RING_BYTES = 131072;
constexpr int LB = 8192;
constexpr int L_F32A = 14 * LB, L_F32B = L_F32A + 16384, L_MISC = L_F32B + 16384;
constexpr int L_CTL = L_MISC + 4096;
constexpr int LDS_BYTES = 155648;

#define GAS __attribute__((address_space(1)))
#define LAS __attribute__((address_space(3)))
typedef unsigned short bf16;
typedef unsigned v4u __attribute__((ext_vector_type(4)));
typedef float f32x4 __attribute__((ext_vector_type(4)));
typedef GAS unsigned gu32;
#define RLX_AGENT __ATOMIC_RELAXED, __HIP_MEMORY_SCOPE_AGENT
#define LDS_WAIT() asm volatile("s_waitcnt lgkmcnt(0)" ::: "memory")
#define VM_WAIT() asm volatile("s_waitcnt vmcnt(0)" ::: "memory")
__device__ __forceinline__ unsigned f2bf(float f) { unsigned u = __builtin_bit_cast(unsigned, f); return (u + 0x7fffu + ((u >> 16) & 1u)) >> 16; }
__device__ __forceinline__ unsigned pk2(float lo, float hi) { return f2bf(lo) | (f2bf(hi) << 16); }
__device__ __forceinline__ float bf2f(unsigned h) { return __builtin_bit_cast(float, h << 16); }
__device__ __forceinline__ float sigm(float x) { return 1.0f / (1.0f + __expf(-x)); }
__device__ __forceinline__ float wave_sum(float v) {
#pragma unroll
    for (int o = 1; o < 64; o <<= 1) v += __shfl_xor(v, o);
    return v;
}
#define XB_TMO      128
#define XB_XCNT(j)  (256  + 64 * (j))
#define XB_XSUB(j)  (1280 + 64 * (j))
#define XB_XGEN(j)  (2304 + 64 * (j))
#define XB_TOP      3328
#define XB_TOPGEN   3392
#define XCD_BAR_WORDS 3456
#define XB_SPIN_CAP (1u << 18)

__device__ __forceinline__ unsigned xb_ld(unsigned* p)              { return __hip_atomic_load(p, __ATOMIC_RELAXED, __HIP_MEMORY_SCOPE_AGENT); }
__device__ __forceinline__ unsigned xb_add(unsigned* p, unsigned v) { return __hip_atomic_fetch_add(p, v, __ATOMIC_RELAXED, __HIP_MEMORY_SCOPE_AGENT); }
__device__ __forceinline__ unsigned xb_xcc_id() { return (unsigned)__builtin_amdgcn_s_getreg((3 << 11) | 20) & 0xFu; }
#define XB_SPIN(cond, bar) do { unsigned _sp = 0; while (cond) { __builtin_amdgcn_s_sleep(1); \
    if ((++_sp & 255u) == 0u) { if (xb_ld(&(bar)[XB_TMO])) break; if (_sp > XB_SPIN_CAP) { atomicAdd(&(bar)[XB_TMO], 1u); break; } } } } while (0)

struct XcdBarrier {
    unsigned* bar; unsigned x;
    volatile LAS unsigned* st;
};

__device__ __forceinline__ XcdBarrier xcd_barrier_post(unsigned* bar, volatile LAS unsigned* st) {
    XcdBarrier b; b.bar = bar; b.x = xb_xcc_id(); b.st = st;
    if (threadIdx.x == 0) (void)xb_add(&bar[XB_XCNT(b.x)], 1u);
    return b;
}
__device__ __forceinline__ void xcd_barrier_complete(unsigned* bar, unsigned x, unsigned& nloc, unsigned& nx) {
    const unsigned G = gridDim.x * gridDim.y * gridDim.z;
    unsigned sum, cnt, mine, sp = 0u;
    for (;;) {
        sum = 0u; cnt = 0u; mine = 0u;
#pragma unroll
        for (unsigned j = 0; j < 16; ++j) { const unsigned c = xb_ld(&bar[XB_XCNT(j)]); sum += c; cnt += (c > 0u) ? 1u : 0u; mine = (j == x) ? c : mine; }
        if (sum == G) break;
        __builtin_amdgcn_s_sleep(1);
        if ((++sp & 255u) == 0u) { if (xb_ld(&bar[XB_TMO])) break; if (sp > XB_SPIN_CAP) { atomicAdd(&bar[XB_TMO], 1u); break; } }
    }
    nloc = mine > 0u ? mine : 1u; nx = cnt > 0u ? cnt : 1u;
}

__device__ __forceinline__ void xcd_barrier(const XcdBarrier& b) {
    asm volatile("s_waitcnt vmcnt(0)" ::: "memory");
    __syncthreads();
    if (threadIdx.x == 0) {
        unsigned* bar = b.bar;
        __builtin_amdgcn_s_waitcnt(0);
        unsigned nloc = b.st[0], nx = b.st[1];
        if (nloc == 0u) { xcd_barrier_complete(bar, b.x, nloc, nx); b.st[0] = nloc; b.st[1] = nx; }
        const unsigned old = xb_add(&bar[XB_XSUB(b.x)], 1u);
        const unsigned gen = old / nloc;
        if (old + 1u == (gen + 1u) * nloc) {
            __builtin_amdgcn_fence(__ATOMIC_RELEASE, "agent");
            asm volatile("s_waitcnt vmcnt(0)" ::: "memory");
            const unsigned og = xb_add(&bar[XB_TOP], 1u);
            const unsigned tg = og / nx;
            if (og + 1u == (tg + 1u) * nx) xb_add(&bar[XB_TOPGEN], 1u);
            else XB_SPIN(xb_ld(&bar[XB_TOPGEN]) == tg, bar);
            __builtin_amdgcn_fence(__ATOMIC_ACQUIRE, "agent");
            xb_add(&bar[XB_XGEN(b.x)], 1u);
            asm volatile("s_waitcnt vmcnt(0)" ::: "memory");
        } else {
            XB_SPIN(xb_ld(&bar[XB_XGEN(b.x)]) == gen, bar);
            __builtin_amdgcn_fence(__ATOMIC_ACQUIRE, "agent");
            asm volatile("s_waitcnt vmcnt(0)" ::: "memory");
        }
    }
    __syncthreads();
}

struct Args { const float* in[35]; float* out; unsigned char* ws; int ph_lo, ph_hi; };
struct KCtx {
    LAS unsigned char* lds; int tid, lane, wave, vcu, G;
    const Args* a;
};
#define IN_X 0
#define IN_C 1
#define IN_CTX 2
#define IN_CCTX 3
#define IN_EG 4
#define IN_EB 5
#define IN_WMOD 6
#define IN_BMOD 7
#define IN_WIN 8
#define IN_MU 9
#define IN_W0 10
#define IN_W2 11
#define IN_A0 12
#define IN_A2 13
#define IN_G2 14
#define IN_KK 15
#define IN_KA 16
#define IN_RK 17
#define IN_GNG 18
#define IN_GNB 19
#define IN_RDEC 20
#define IN_RGNG 21
#define IN_RGNB 22
#define IN_WOUT 23
#define IN_LN1G 24
#define IN_LN1B 25
#define IN_RG 26
#define IN_RGB 27
#define IN_RE 28
#define IN_REB 29
#define IN_EWG 30
#define IN_EWU 31
#define IN_EWD 32
#define IN_LN2G 33
#define IN_LN2B 34

__device__ __forceinline__ void transpose_item(const float* W, int K, int N, bf16* WT, int row_off, LAS float* scr, int item, int lane) {
    const int nblk = N / 32, kb = item / nblk, nb = item % nblk, k0 = 64 * kb, n0 = 32 * nb;
#pragma unroll 8
    for (int i = 0; i < 32; ++i) { const int kk = 2 * i + (lane >> 5); scr[kk * 33 + (lane & 31)] = W[(size_t)(k0 + kk) * N + n0 + (lane & 31)]; }
    LDS_WAIT(); asm volatile("" ::: "memory");
    const int c = lane & 7;
#pragma unroll
    for (int j = 0; j < 4; ++j) { const int n = (lane >> 3) + 8 * j; const LAS float* s = scr + (8 * c) * 33 + n;
        v4u o; o.x = pk2(s[0 * 33], s[1 * 33]); o.y = pk2(s[2 * 33], s[3 * 33]); o.z = pk2(s[4 * 33], s[5 * 33]); o.w = pk2(s[6 * 33], s[7 * 33]);
        *(GAS v4u*)(WT + (size_t)(row_off + n0 + n) * K + k0 + 8 * c) = o; }
    LDS_WAIT(); asm volatile("" ::: "memory");
}

__device__ __forceinline__ void phase0(const KCtx& X) {
    float* mod = (float*)(X.a->ws + WS_MOD);
    LAS float* sc = (LAS float*)X.lds;
    LAS float* red = sc + 3072;
    const float* wmod = X.a->in[IN_WMOD];
    for (int tile = X.vcu; tile < 192; tile += X.G) {
        for (int i = X.tid; i < 3072; i += NTHR) { const int b = i >> 10, k = i & 1023; const float c = b < 2 ? X.a->in[IN_C][b * 1024 + k] : X.a->in[IN_CCTX][k]; sc[i] = c * sigm(c); }
        __syncthreads();
        const int cq = X.tid & 7, kg = X.tid >> 3; float acc[3][4];
#pragma unroll
        for (int b = 0; b < 3; ++b)
#pragma unroll
            for (int j = 0; j < 4; ++j) acc[b][j] = 0.f;
#pragma unroll 4
        for (int kk = 0; kk < 16; ++kk) { const int k = kg * 16 + kk; const f32x4 w = *(const f32x4*)(wmod + (size_t)k * 6144 + tile * 32 + cq * 4);
#pragma unroll
            for (int b = 0; b < 3; ++b) { const float s = sc[b * 1024 + k];
#pragma unroll
                for (int j = 0; j < 4; ++j) acc[b][j] += s * w[j]; } }
#pragma unroll
        for (int b = 0; b < 3; ++b)
#pragma unroll
            for (int j = 0; j < 4; ++j) red[kg * 96 + cq * 12 + b * 4 + j] = acc[b][j];
        __syncthreads();
        if (X.tid < 96) { float s = 0.f; for (int g = 0; g < 64; ++g) s += red[g * 96 + X.tid];
            const int q = X.tid / 12, b = (X.tid % 12) / 4, j = X.tid & 3, col = tile * 32 + q * 4 + j; mod[b * 6144 + col] = s + X.a->in[IN_BMOD][col]; }
        __syncthreads();
    }
    LAS float* scr = (LAS float*)(X.lds + 40960 + X.wave * 8704);
    const int gw = X.vcu * NWAVES + X.wave, NGW = X.G * NWAVES;
    bf16* WinT = (bf16*)(X.a->ws + WS_WIN); bf16* WoutT = (bf16*)(X.a->ws + WS_WOUT); bf16* W2T = (bf16*)(X.a->ws + WS_W2T); bf16* A2T = (bf16*)(X.a->ws + WS_A2T); bf16* G2T = (bf16*)(X.a->ws + WS_G2T);
    constexpr int I_IN = 16 * 124, I_OUT = 16 * 32, I_L = 16, I_G = 32;
    constexpr int NIT = I_IN + I_OUT + 4 * I_L + I_G;
    for (int it = gw; it < NIT; it += NGW) {
        int r = it;
        if (r < I_IN) { transpose_item(X.a->in[IN_WIN], 1024, NIN, WinT, 0, scr, r, X.lane); continue; } r -= I_IN;
        if (r < I_OUT) { transpose_item(X.a->in[IN_WOUT], 1024, 1024, WoutT, 0, scr, r, X.lane); continue; } r -= I_OUT;
        if (r < I_L) { transpose_item(X.a->in[IN_W2], 64, 512, W2T, 0, scr, r, X.lane); continue; } r -= I_L;
        if (r < I_L) { transpose_item(X.a->in[IN_W2] + 64 * 512, 64, 512, W2T + 512 * 64, 0, scr, r, X.lane); continue; } r -= I_L;
        if (r < I_L) { transpose_item(X.a->in[IN_A2], 64, 512, A2T, 0, scr, r, X.lane); continue; } r -= I_L;
        if (r < I_L) { transpose_item(X.a->in[IN_A2] + 64 * 512, 64, 512, A2T + 512 * 64, 0, scr, r, X.lane); continue; } r -= I_L;
        transpose_item(X.a->in[IN_G2], 128, 512, G2T, 0, scr, r, X.lane);
    }
    const int gt = X.vcu * NTHR + X.tid, NGT = X.G * NTHR;
    for (int i = gt; i < 128 * 1024 / 8; i += NGT) *(GAS v4u*)(WinT + (size_t)NIN * 1024 + (size_t)i * 8) = (v4u){0u, 0u, 0u, 0u};
    float* RTt = (float*)(X.a->ws + WS_RT);
    for (int i = gt; i < 36 * 1024; i += NGT) { const int e = i >> 10, k = i & 1023; RTt[i] = e < 4 ? X.a->in[IN_RG][k * 4 + e] : X.a->in[IN_RE][k * 32 + (e - 4)]; }
    float* rope = (float*)(X.a->ws + WS_ROPE);
    for (int i = gt; i < 128 * 32; i += NGT) { const int pos = i >> 5, f = i & 31; const float inv = exp2f(-(float)f * (13.287712379549449f / 32.0f)); const float ang = (float)pos * inv;
        float rv = ang * 0.15915494309189535f; rv -= rintf(rv); rope[2 * i] = __builtin_amdgcn_cosf(rv); rope[2 * i + 1] = __builtin_amdgcn_sinf(rv); }
}

__device__ __forceinline__ void phase1(const KCtx& X) {
    const float* mod = (const float*)(X.a->ws + WS_MOD); float* stats = (float*)(X.a->ws + WS_STATS); bf16* U = (bf16*)(X.a->ws + WS_U);
    const int gw = X.vcu * NWAVES + X.wave, NGW = X.G * NWAVES;
    for (int m = gw; m < MALL; m += NGW) {
        const float* src = m < MLAT ? X.a->in[IN_X] + (size_t)m * D : X.a->in[IN_CTX] + (size_t)(m - MLAT) * D;
        const float* mr = mod + (m < MLAT ? (m >> 13) : 2) * 6144;
        f32x4 v[4]; float s = 0.f;
#pragma unroll
        for (int j = 0; j < 4; ++j) { v[j] = *(const f32x4*)(src + 4 * X.lane + 256 * j); s += (v[j].x + v[j].y) + (v[j].z + v[j].w); }
        const float mean = wave_sum(s) * (1.f / D); float s2 = 0.f;
#pragma unroll
        for (int j = 0; j < 4; ++j) { v[j] = v[j] - mean; s2 += (v[j].x * v[j].x + v[j].y * v[j].y) + (v[j].z * v[j].z + v[j].w * v[j].w); }
        const float rstd = 1.f / sqrtf(wave_sum(s2) * (1.f / D) + LN_EPS);
        if (X.lane == 0) { stats[2 * m] = mean; stats[2 * m + 1] = rstd; }
#pragma unroll
        for (int j = 0; j < 4; ++j) { const int c = 4 * X.lane + 256 * j;
            const f32x4 g = *(const f32x4*)(X.a->in[IN_EG] + c), bb = *(const f32x4*)(X.a->in[IN_EB] + c), sh = *(const f32x4*)(mr + c), sc = *(const f32x4*)(mr + 1024 + c);
            const f32x4 h = v[j] * rstd * g + bb; const f32x4 u = h * (sc + 1.0f) + sh;
            unsigned long long o = (unsigned long long)pk2(u.x, u.y) | ((unsigned long long)pk2(u.z, u.w) << 32);
            *(unsigned long long*)(U + (size_t)m * D + c) = o; }
    }
}
__device__ __forceinline__ int sw(int r, int c) { return r * 64 + ((((c >> 3) ^ r) & 7) << 3) + (c & 7); }
#define BUF(i) ((LAS bf16*)(X.lds + (i) * LB))
#define MM64(XE, YE, KD, OUT) do { _Pragma("unroll 1") for (int q_ = 0; q_ < 8; ++q_) { const int a = q_ * 8 + X.wave, b = X.lane; float acc = 0.f; \
    _Pragma("unroll 8") for (int k = 0; k < (KD); ++k) acc += (XE) * (YE); OUT; } } while (0)
#define MM64_2(XE1, YE1, XE2, YE2, KD, OUT) do { _Pragma("unroll 1") for (int q_ = 0; q_ < 8; ++q_) { const int a = q_ * 8 + X.wave, b = X.lane; float acc = 0.f; \
    _Pragma("unroll 8") for (int k = 0; k < (KD); ++k) acc += (XE1) * (YE1) - (XE2) * (YE2); OUT; } } while (0)

__device__ __forceinline__ void load_shift8(const bf16* Pb, const float* mu, int b, bool isctx, int t, int c0, float (&o)[8]) {
    const size_t row = isctx ? (size_t)(MLAT + b * CTX + t) : (size_t)(b * T + t);
    const bf16* p = Pb + row * PP + c0;
    const v4u self = *(const v4u*)p;
    v4u n0 = (v4u){0u, 0u, 0u, 0u}, n1 = n0, n2 = n0, n3 = n0;
    if (isctx) { if (t > 0) n0 = *(const v4u*)(p - PP); if (t < CTX - 1) n1 = *(const v4u*)(p + PP); n2 = n0; n3 = n1; }
    else { const int col = t & 63;
        if (col > 0) n0 = *(const v4u*)(p - PP); if (col < 63) n1 = *(const v4u*)(p + PP);
        if (t >= 64) n2 = *(const v4u*)(p - 64 * PP); if (t < T - 64) n3 = *(const v4u*)(p + 64 * PP); }
    const f32x4 m0 = *(const f32x4*)(mu + c0), m1 = *(const f32x4*)(mu + c0 + 4);
    const unsigned sw_[4] = {self.x, self.y, self.z, self.w};
    const unsigned a0[4] = {n0.x, n0.y, n0.z, n0.w}, a1[4] = {n1.x, n1.y, n1.z, n1.w}, a2[4] = {n2.x, n2.y, n2.z, n2.w}, a3[4] = {n3.x, n3.y, n3.z, n3.w};
#pragma unroll
    for (int w = 0; w < 4; ++w) {
        const int j0 = 2 * w, j1 = 2 * w + 1;
        const float p0 = bf2f(sw_[w] & 0xffffu), p1 = bf2f(sw_[w] >> 16);
        const unsigned s0 = ((j0 & 3) == 0) ? a0[w] : a2[w];
        const unsigned s1 = ((j1 & 3) == 1) ? a1[w] : a3[w];
        const float q0 = bf2f(s0 & 0xffffu), q1 = bf2f(s1 >> 16);
        const float mu0 = j0 < 4 ? m0[j0] : m1[j0 - 4], mu1 = j1 < 4 ? m0[j1] : m1[j1 - 4];
        o[j0] = p0 + mu0 * (q0 - p0); o[j1] = p1 + mu1 * (q1 - p1);
    }
}
__device__ __forceinline__ void store8(LAS bf16* buf, int r, int chunk, const float (&v)[8]) {
    v4u o; o.x = pk2(v[0], v[1]); o.y = pk2(v[2], v[3]); o.z = pk2(v[4], v[5]); o.w = pk2(v[6], v[7]);
    *(LAS v4u*)(buf + r * 64 + (((chunk ^ r) & 7) << 3)) = o;
}

typedef short bf16x8 __attribute__((ext_vector_type(8)));
typedef short s16x4 __attribute__((ext_vector_type(4)));
typedef unsigned u32x2 __attribute__((ext_vector_type(2)));
__device__ __forceinline__ bf16x8 fr_row(const LAS bf16* buf, int r0, int ks, int lane) {
    const int row = r0 + (lane & 15), ch = 4 * ks + (lane >> 4);
    return *(const LAS bf16x8*)(buf + row * 64 + (((ch ^ row) & 7) << 3));
}
__device__ __forceinline__ bf16x8 fr_tr(const LAS bf16* buf, int c0, int ks, int lane) {
    const int g = lane >> 4, q = (lane >> 2) & 3, p = lane & 3, col = c0 + 4 * p;
    const int k0 = 32 * ks + 8 * g + q, k1 = k0 + 4;
    const s16x4 lo = __builtin_amdgcn_ds_read_tr16_b64_v4i16((LAS s16x4*)(buf + k0 * 64 + ((((col >> 3) ^ k0) & 7) << 3) + (col & 7)));
    const s16x4 hi = __builtin_amdgcn_ds_read_tr16_b64_v4i16((LAS s16x4*)(buf + k1 * 64 + ((((col >> 3) ^ k1) & 7) << 3) + (col & 7)));
    return (bf16x8){lo[0], lo[1], lo[2], lo[3], hi[0], hi[1], hi[2], hi[3]};
}
__device__ __forceinline__ void st4(LAS bf16* buf, int r, int c0, float v0, float v1, float v2, float v3) {
    u32x2 o; o.x = pk2(v0, v1); o.y = pk2(v2, v3); *(LAS u32x2*)(buf + sw(r, c0)) = o;
}
__device__ __forceinline__ f32x4 ld4(const LAS bf16* buf, int r, int c0) {
    const u32x2 o = *(const LAS u32x2*)(buf + sw(r, c0)); return (f32x4){bf2f(o.x & 0xffffu), bf2f(o.x >> 16), bf2f(o.y & 0xffffu), bf2f(o.y >> 16)};
}
__device__ __forceinline__ f32x4 mk4(float a, float b, float c, float d) { return (f32x4){a, b, c, d}; }
__device__ __forceinline__ void stg4(bf16* p, float v0, float v1, float v2, float v3) { u32x2 o; o.x = pk2(v0, v1); o.y = pk2(v2, v3); *(u32x2*)p = o; }
#define MMA_NAT(KX, BX, KY, BY, EPI) do { int ln_ = X.lane; asm volatile("" : "+v"(ln_)); const int ta_ = X.wave & 3, a_ = 16 * ta_ + (ln_ & 15); \
    const bf16x8 x0_ = KX(BX, 16 * ta_, 0, ln_), x1_ = KX(BX, 16 * ta_, 1, ln_); \
    _Pragma("unroll") for (int tt_ = 0; tt_ < 2; ++tt_) { const int tb_ = 2 * (X.wave >> 2) + tt_; const int b0_ = 16 * tb_ + 4 * (ln_ >> 4); \
        const bf16x8 y0_ = KY(BY, 16 * tb_, 0, ln_), y1_ = KY(BY, 16 * tb_, 1, ln_); f32x4 acc = {0.f, 0.f, 0.f, 0.f}; \
        acc = __builtin_amdgcn_mfma_f32_16x16x32_bf16(y0_, x0_, acc, 0, 0, 0); acc = __builtin_amdgcn_mfma_f32_16x16x32_bf16(y1_, x1_, acc, 0, 0, 0); \
        { EPI; } } } while (0)
#define MMA_NAT2(KX1, BX1, KY1, BY1, KX2, BX2, KY2, BY2, EPI) do { int ln_ = X.lane; asm volatile("" : "+v"(ln_)); const int ta_ = X.wave & 3, a_ = 16 * ta_ + (ln_ & 15); \
    const bf16x8 x0_ = KX1(BX1, 16 * ta_, 0, ln_), x1_ = KX1(BX1, 16 * ta_, 1, ln_), x2_ = KX2(BX2, 16 * ta_, 0, ln_), x3_ = KX2(BX2, 16 * ta_, 1, ln_); \
    _Pragma("unroll") for (int tt_ = 0; tt_ < 2; ++tt_) { const int tb_ = 2 * (X.wave >> 2) + tt_; const int b0_ = 16 * tb_ + 4 * (ln_ >> 4); \
        const bf16x8 y0_ = KY1(BY1, 16 * tb_, 0, ln_), y1_ = KY1(BY1, 16 * tb_, 1, ln_), y2_ = KY2(BY2, 16 * tb_, 0, ln_), y3_ = KY2(BY2, 16 * tb_, 1, ln_); \
        f32x4 acc = {0.f, 0.f, 0.f, 0.f}, acn = {0.f, 0.f, 0.f, 0.f}; \
        acc = __builtin_amdgcn_mfma_f32_16x16x32_bf16(y0_, x0_, acc, 0, 0, 0); acc = __builtin_amdgcn_mfma_f32_16x16x32_bf16(y1_, x1_, acc, 0, 0, 0); \
        acn = __builtin_amdgcn_mfma_f32_16x16x32_bf16(y2_, x2_, acn, 0, 0, 0); acn = __builtin_amdgcn_mfma_f32_16x16x32_bf16(y3_, x3_, acn, 0, 0, 0); acc = acc - acn; \
        { EPI; } } } while (0)

template <int DIR> __device__ __forceinline__ void rwkv_dir(const KCtx& X, int b, int h, int blk, bool isctx, int t0) {
    const bf16* Pb = (const bf16*)(X.a->ws + WS_P);
    LAS bf16 *SR = BUF(0), *SK = BUF(1), *SV = BUF(2), *SKK = BUF(3), *TL = BUF(4), *LA = BUF(5), *W2h = BUF(6), *A2h = BUF(7);
    LAS bf16 *AKA = BUF(4), *BKR = BUF(5), *BBR = BUF(6), *AM = BUF(7), *RT = BUF(8), *AT = BUF(9), *KB = BUF(10), *BB = BUF(11), *VA = BUF(13), *PPm = BUF(16), *QQ = BUF(4);
    LAS bf16 *MA = BUF(12), *MB = BUF(15), *PA = BUF(14), *PB = BUF(16);
    LAS float* F32A = (LAS float*)(X.lds + L_F32A); LAS float* F32B = (LAS float*)(X.lds + L_F32B);
    LAS float* eL = (LAS float*)(X.lds + L_MISC + 512); LAS float* TOT = eL + 64; LAS float* BON = TOT + 512;
    const int hb = h * 64;
    { const int tok = X.tid >> 3, sub = X.tid & 7; float v[8];
      load_shift8(Pb, X.a->in[IN_MU], b, isctx, t0 + tok, C_LW + DIR * 64 + 8 * sub, v);
#pragma unroll
      for (int j = 0; j < 8; ++j) { const float e = __expf(2.0f * v[j]); v[j] = 1.0f - 2.0f / (e + 1.0f); }
      store8(TL, tok, sub, v);
      load_shift8(Pb, X.a->in[IN_MU], b, isctx, t0 + tok, C_LA + DIR * 64 + 8 * sub, v);
      store8(LA, tok, sub, v);
      const bf16* w2 = (const bf16*)(X.a->ws + WS_W2T) + (size_t)(DIR * 512 + hb + tok) * 64 + 8 * sub;
      const bf16* a2 = (const bf16*)(X.a->ws + WS_A2T) + (size_t)(DIR * 512 + hb + tok) * 64 + 8 * sub;
      *(LAS v4u*)(W2h + tok * 64 + (((sub ^ tok) & 7) << 3)) = *(const v4u*)w2;
      *(LAS v4u*)(A2h + tok * 64 + (((sub ^ tok) & 7) << 3)) = *(const v4u*)a2; }
    __syncthreads();
    MMA_NAT(fr_row, TL, fr_row, W2h, { const f32x4 w0 = *(const f32x4*)(X.a->in[IN_W0] + DIR * 512 + hb + b0_); f32x4 o;
        _Pragma("unroll") for (int i = 0; i < 4; ++i) o[i] = -0.6065306597126334f * sigm(w0[i] + acc[i]); *(LAS f32x4*)(F32A + a_ * 64 + b0_) = o; });
    MMA_NAT(fr_row, LA, fr_row, A2h, { const f32x4 a0 = *(const f32x4*)(X.a->in[IN_A0] + DIR * 512 + hb + b0_); f32x4 o;
        _Pragma("unroll") for (int i = 0; i < 4; ++i) o[i] = sigm(a0[i] + acc[i]); *(LAS f32x4*)(F32B + a_ * 64 + b0_) = o; });
    __syncthreads();
    { const int n = X.lane, g = X.wave; float lw8[8], inc[8]; float run = 0.f;
#pragma unroll
      for (int i = 0; i < 8; ++i) lw8[i] = F32A[(8 * g + i) * 64 + n];
#pragma unroll
      for (int ii = 0; ii < 8; ++ii) { const int i = DIR ? 7 - ii : ii; run += lw8[i]; inc[i] = run; }
      TOT[g * 64 + n] = run;
      __syncthreads();
      float off = 0.f, tot = 0.f;
#pragma unroll
      for (int g2 = 0; g2 < 8; ++g2) { const float tv = TOT[g2 * 64 + n]; tot += tv; if (DIR ? (g2 > g) : (g2 < g)) off += tv; }
      if (g == 0) eL[n] = __expf(tot);
      const float ka = X.a->in[IN_KA][hb + n], rk = X.a->in[IN_RK][hb + n];
#pragma unroll
      for (int i = 0; i < 8; ++i) { const int t = 8 * g + i; const float li = off + inc[i], le = li - lw8[i];
          const float av = F32B[t * 64 + n], r = bf2f(SR[sw(t, n)]), k = bf2f(SK[sw(t, n)]), kk = bf2f(SKK[sw(t, n)]);
          const float kd = k * (1.0f + (av - 1.0f) * ka), ei = __expf(li), en = __expf(-li);
          RT[sw(t, n)] = (bf16)f2bf(r * ei); AT[sw(t, n)] = (bf16)f2bf(kk * __expf(le)); KB[sw(t, n)] = (bf16)f2bf(kd * en); BB[sw(t, n)] = (bf16)f2bf(kk * av * en);
          const float bs = wave_sum(r * kd * rk);
          if (n == 0) { if (DIR == 0) BON[t] = bs; else BON[t] += bs; } } }
    __syncthreads();
    MMA_NAT(fr_row, KB, fr_row, AT, { float o[4]; _Pragma("unroll") for (int i = 0; i < 4; ++i) o[i] = (DIR ? a_ > b0_ + i : a_ < b0_ + i) ? acc[i] : 0.f; st4(AKA, a_, b0_, o[0], o[1], o[2], o[3]); });
    MMA_NAT(fr_row, BB, fr_row, AT, { float o[4]; _Pragma("unroll") for (int i = 0; i < 4; ++i) o[i] = (DIR ? a_ > b0_ + i : a_ < b0_ + i) ? acc[i] : 0.f; st4(AM, a_, b0_, o[0], o[1], o[2], o[3]);
        st4(MA, a_, b0_, (a_ == b0_ ? 1.f : 0.f) - o[0], (a_ == b0_ + 1 ? 1.f : 0.f) - o[1], (a_ == b0_ + 2 ? 1.f : 0.f) - o[2], (a_ == b0_ + 3 ? 1.f : 0.f) - o[3]); });
    MMA_NAT(fr_row, KB, fr_row, RT, { float o[4]; _Pragma("unroll") for (int i = 0; i < 4; ++i) o[i] = (DIR ? a_ >= b0_ + i : a_ <= b0_ + i) ? acc[i] : 0.f; st4(BKR, a_, b0_, o[0], o[1], o[2], o[3]); });
    MMA_NAT(fr_row, BB, fr_row, RT, { float o[4]; _Pragma("unroll") for (int i = 0; i < 4; ++i) o[i] = (DIR ? a_ >= b0_ + i : a_ <= b0_ + i) ? acc[i] : 0.f; st4(BBR, a_, b0_, o[0], o[1], o[2], o[3]); });
    __syncthreads();
    MMA_NAT(fr_tr, SV, fr_tr, AKA, { st4(VA, a_, b0_, acc[0], acc[1], acc[2], acc[3]); });
    MMA_NAT(fr_row, AM, fr_tr, AM, { st4(PA, a_, b0_, acc[0], acc[1], acc[2], acc[3]); });
    __syncthreads();
#define NEU_M(MS, PS, MD) MMA_NAT(fr_row, MS, fr_tr, PS, { const f32x4 m_ = ld4(MS, a_, b0_); st4(MD, a_, b0_, m_[0] + acc[0], m_[1] + acc[1], m_[2] + acc[2], m_[3] + acc[3]); })
#define NEU_P(PS, PD) MMA_NAT(fr_row, PS, fr_tr, PS, { st4(PD, a_, b0_, acc[0], acc[1], acc[2], acc[3]); })
    NEU_M(MA, PA, MB); NEU_P(PA, PB); __syncthreads();
    NEU_M(MB, PB, MA); NEU_P(PB, PA); __syncthreads();
    NEU_M(MA, PA, MB); NEU_P(PA, PB); __syncthreads();
    NEU_M(MB, PB, MA); NEU_P(PB, PA); __syncthreads();
    NEU_M(MA, PA, MB); __syncthreads();
#undef NEU_M
#undef NEU_P
    MMA_NAT(fr_tr, AT, fr_tr, MB, { st4(PPm, a_, b0_, acc[0], acc[1], acc[2], acc[3]); });
    MMA_NAT(fr_row, VA, fr_tr, MB, { st4(QQ, a_, b0_, acc[0], acc[1], acc[2], acc[3]); });
    __syncthreads();
    const int chain = (b * 8 + h) * 2 + DIR;
    const int s = DIR ? (blk < 4 ? 3 - blk : 4 + 127 - (blk - 4)) : blk;
    bf16* PhiT = (bf16*)(X.a->ws + WS_PHIPSI) + ((size_t)chain * NCHUNK + s) * 8192; bf16* Psi = PhiT + 4096;
    MMA_NAT(fr_tr, BB, fr_row, PPm, { const float e = eL[a_]; stg4(PhiT + a_ * 64 + b0_, (a_ == b0_ ? e : 0.f) - e * acc[0], (a_ == b0_ + 1 ? e : 0.f) - e * acc[1], (a_ == b0_ + 2 ? e : 0.f) - e * acc[2], (a_ == b0_ + 3 ? e : 0.f) - e * acc[3]); });
    MMA_NAT2(fr_tr, SV, fr_tr, KB, fr_row, QQ, fr_tr, BB, { const f32x4 e = *(const LAS f32x4*)(eL + b0_); stg4(Psi + a_ * 64 + b0_, e[0] * acc[0], e[1] * acc[1], e[2] * acc[2], e[3] * acc[3]); });
    if (!isctx) {
        const int lb = blk - 4;
        bf16* GT = (bf16*)X.a->out + ((size_t)chain * 128 + lb) * 4096;
        MMA_NAT(fr_tr, BBR, fr_row, PPm, { const f32x4 r_ = ld4(RT, a_, b0_); stg4(GT + a_ * 64 + b0_, r_[0] - acc[0], r_[1] - acc[1], r_[2] - acc[2], r_[3] - acc[3]); });
        bf16* Hb = (bf16*)(X.a->ws + WS_HB) + ((size_t)(b * T + t0)) * 512 + hb;
        MMA_NAT2(fr_tr, BKR, fr_tr, SV, fr_tr, BBR, fr_row, QQ, { bf16* hp = Hb + (size_t)a_ * 512 + b0_; f32x4 pv = mk4(0.f, 0.f, 0.f, 0.f);
            if (DIR) { const u32x2 o = *(const u32x2*)hp; pv = mk4(bf2f(o.x & 0xffffu), bf2f(o.x >> 16), bf2f(o.y & 0xffffu), bf2f(o.y >> 16)); }
            stg4(hp, pv[0] + acc[0], pv[1] + acc[1], pv[2] + acc[2], pv[3] + acc[3]); });
    }
    __syncthreads();
}

__device__ __forceinline__ void rwkv_unit(const KCtx& X, int unit) {
    const int blk = unit % NCHUNK, bh = unit / NCHUNK, b = bh >> 3, h = bh & 7;
    const bool isctx = blk < 4; const int t0 = isctx ? blk * 64 : (blk - 4) * 64;
    const bf16* Pb = (const bf16*)(X.a->ws + WS_P);
    LAS bf16 *SR = BUF(0), *SK = BUF(1), *SV = BUF(2), *SKK = BUF(3);
    const int hb = h * 64;
    { const int tok = X.tid >> 3, sub = X.tid & 7; float v[8];
      load_shift8(Pb, X.a->in[IN_MU], b, isctx, t0 + tok, C_R + hb + 8 * sub, v); store8(SR, tok, sub, v);
      load_shift8(Pb, X.a->in[IN_MU], b, isctx, t0 + tok, C_V + hb + 8 * sub, v); store8(SV, tok, sub, v);
      load_shift8(Pb, X.a->in[IN_MU], b, isctx, t0 + tok, C_K + hb + 8 * sub, v); store8(SK, tok, sub, v);
      float ss = 0.f;
#pragma unroll
      for (int j = 0; j < 8; ++j) { v[j] *= X.a->in[IN_KK][hb + 8 * sub + j]; ss += v[j] * v[j]; }
      ss += __shfl_xor(ss, 1); ss += __shfl_xor(ss, 2); ss += __shfl_xor(ss, 4);
      const float inv = 1.0f / fmaxf(sqrtf(ss), 1e-12f);
#pragma unroll
      for (int j = 0; j < 8; ++j) v[j] *= inv;
      store8(SKK, tok, sub, v); }
    __syncthreads();
    rwkv_dir<0>(X, b, h, blk, isctx, t0);
    rwkv_dir<1>(X, b, h, blk, isctx, t0);
    if (!isctx) {
        LAS float* BON = (LAS float*)(X.lds + L_MISC + 512) + 64 + 512;
        LAS bf16 *SLG0 = BUF(4), *SLG1 = BUF(5), *G2h0 = BUF(6), *G2h1 = BUF(7);
        { const int tok = X.tid >> 3, sub = X.tid & 7; float v[8];
#pragma unroll
          for (int hh = 0; hh < 2; ++hh) { load_shift8(Pb, X.a->in[IN_MU], b, false, t0 + tok, C_LG + 64 * hh + 8 * sub, v);
#pragma unroll
              for (int j = 0; j < 8; ++j) v[j] = sigm(v[j]);
              store8(hh ? SLG1 : SLG0, tok, sub, v);
              *(LAS v4u*)((hh ? G2h1 : G2h0) + tok * 64 + (((sub ^ tok) & 7) << 3)) = *(const v4u*)((const bf16*)(X.a->ws + WS_G2T) + (size_t)(hb + tok) * 128 + 64 * hh + 8 * sub); } }
        __syncthreads();
        bf16* BV = (bf16*)(X.a->ws + WS_BV) + ((size_t)(b * T + t0)) * 512 + hb; bf16* GG = (bf16*)(X.a->ws + WS_GG) + ((size_t)(b * T + t0)) * 512 + hb;
        { int ln_ = X.lane; asm volatile("" : "+v"(ln_)); const int ta_ = X.wave & 3, a_ = 16 * ta_ + (ln_ & 15);
          const bf16x8 x0 = fr_row(SLG0, 16 * ta_, 0, ln_), x1 = fr_row(SLG0, 16 * ta_, 1, ln_), x2 = fr_row(SLG1, 16 * ta_, 0, ln_), x3 = fr_row(SLG1, 16 * ta_, 1, ln_);
          const float bon = BON[a_];
#pragma unroll
          for (int tt = 0; tt < 2; ++tt) { const int tb = 2 * (X.wave >> 2) + tt, b0_ = 16 * tb + 4 * (ln_ >> 4);
              f32x4 acc = {0.f, 0.f, 0.f, 0.f};
              acc = __builtin_amdgcn_mfma_f32_16x16x32_bf16(fr_row(G2h0, 16 * tb, 0, ln_), x0, acc, 0, 0, 0); acc = __builtin_amdgcn_mfma_f32_16x16x32_bf16(fr_row(G2h0, 16 * tb, 1, ln_), x1, acc, 0, 0, 0);
              acc = __builtin_amdgcn_mfma_f32_16x16x32_bf16(fr_row(G2h1, 16 * tb, 0, ln_), x2, acc, 0, 0, 0); acc = __builtin_amdgcn_mfma_f32_16x16x32_bf16(fr_row(G2h1, 16 * tb, 1, ln_), x3, acc, 0, 0, 0);
              const f32x4 vv = ld4(SV, a_, b0_);
              stg4(GG + (size_t)a_ * 512 + b0_, acc[0], acc[1], acc[2], acc[3]); stg4(BV + (size_t)a_ * 512 + b0_, bon * vv[0], bon * vv[1], bon * vv[2], bon * vv[3]); } }
        __syncthreads();
    }
}

__device__ __forceinline__ void rwkv_scan(const KCtx& X, int chain) {
    LAS bf16* SB0 = BUF(0); LAS bf16* SB1 = BUF(1); LAS bf16* PH0 = BUF(2); LAS bf16* PH1 = BUF(3);
    const bf16* PP_ = (const bf16*)(X.a->ws + WS_PHIPSI) + (size_t)chain * NCHUNK * 8192;
    bf16* Sc = (bf16*)X.a->out + 16 * MiB + (size_t)chain * 128 * 4096;
    const int row = X.tid >> 3, sub = X.tid & 7;
    { const v4u z = {0u, 0u, 0u, 0u}; *(LAS v4u*)(SB0 + X.tid * 8) = z; *(LAS v4u*)(PH0 + row * 64 + (((sub ^ row) & 7) << 3)) = *(const v4u*)(PP_ + row * 64 + 8 * sub); }
    __syncthreads();
    int ln_ = X.lane; asm volatile("" : "+v"(ln_));
    const int ta_ = X.wave & 3, a_ = 16 * ta_ + (ln_ & 15), tb0 = 2 * (X.wave >> 2), bq = 4 * (ln_ >> 4);
#pragma unroll 1
    for (int s = 0; s < NCHUNK - 1; ++s) {
        LAS bf16* Scur = (s & 1) ? SB1 : SB0; LAS bf16* Snxt = (s & 1) ? SB0 : SB1; LAS bf16* Pcur = (s & 1) ? PH1 : PH0; LAS bf16* Pnxt = (s & 1) ? PH0 : PH1;
        const bf16* ph = PP_ + (size_t)s * 8192;
        const v4u phn = *(const v4u*)(ph + 8192 + row * 64 + 8 * sub);
        const u32x2 ps0 = *(const u32x2*)(ph + 4096 + a_ * 64 + 16 * tb0 + bq), ps1 = *(const u32x2*)(ph + 4096 + a_ * 64 + 16 * (tb0 + 1) + bq);
        const bf16x8 x0 = fr_row(Scur, 16 * ta_, 0, ln_), x1 = fr_row(Scur, 16 * ta_, 1, ln_);
#pragma unroll
        for (int tt = 0; tt < 2; ++tt) { const int tb = tb0 + tt, b0_ = 16 * tb + bq; const u32x2 ps = tt ? ps1 : ps0;
            f32x4 acc = {bf2f(ps.x & 0xffffu), bf2f(ps.x >> 16), bf2f(ps.y & 0xffffu), bf2f(ps.y >> 16)};
            acc = __builtin_amdgcn_mfma_f32_16x16x32_bf16(fr_row(Pcur, 16 * tb, 0, ln_), x0, acc, 0, 0, 0); acc = __builtin_amdgcn_mfma_f32_16x16x32_bf16(fr_row(Pcur, 16 * tb, 1, ln_), x1, acc, 0, 0, 0);
            st4(Snxt, a_, b0_, acc[0], acc[1], acc[2], acc[3]);
            if (s + 1 >= 4) stg4(Sc + (size_t)(s + 1 - 4) * 4096 + a_ * 64 + b0_, acc[0], acc[1], acc[2], acc[3]); }
        *(LAS v4u*)(Pnxt + row * 64 + (((sub ^ row) & 7) << 3)) = phn;
        __syncthreads();
    }
}

__device__ __forceinline__ void rwkv_out_pair(const KCtx& X, int pair) {
    const int wsub = X.wave >> 2;
    const bf16* Sc = (const bf16*)X.a->out + 16 * MiB; const bf16* GTb = (const bf16*)X.a->out;
#pragma unroll
    for (int i = 0; i < 8; ++i) { const int unit = 2 * pair + (i >> 2), lb = unit & 127, bh = unit >> 7, cf = bh * 2, cr = cf + 1; const int kind = i & 3;
        const bf16* src = kind == 0 ? GTb + ((size_t)cf * 128 + lb) * 4096 : kind == 1 ? GTb + ((size_t)cr * 128 + lb) * 4096 : kind == 2 ? Sc + ((size_t)cf * 128 + lb) * 4096 : Sc + ((size_t)cr * 128 + (127 - lb)) * 4096;
        const int row = X.tid >> 3, sub = X.tid & 7;
        *(LAS v4u*)(BUF(i) + row * 64 + (((sub ^ row) & 7) << 3)) = *(const v4u*)(src + row * 64 + 8 * sub); }
    __syncthreads();
    const int unit = 2 * pair + wsub, lb = unit & 127, bh = unit >> 7, b = bh >> 3, h = bh & 7, hb = h * 64, t0 = lb * 64;
    LAS bf16 *GF = BUF(4 * wsub), *GR = BUF(4 * wsub + 1), *SF = BUF(4 * wsub + 2), *SRv = BUF(4 * wsub + 3);
    int ln_ = X.lane; asm volatile("" : "+v"(ln_));
    const int ta_ = X.wave & 3, a_ = 16 * ta_ + (ln_ & 15), bq = 4 * (ln_ >> 4);
    const size_t trow = (size_t)(b * T + t0 + a_);
    const bf16* Hb = (const bf16*)(X.a->ws + WS_HB) + trow * 512 + hb; const bf16* BV = (const bf16*)(X.a->ws + WS_BV) + trow * 512 + hb; const bf16* GG = (const bf16*)(X.a->ws + WS_GG) + trow * 512 + hb;
    bf16* O = (bf16*)(X.a->ws + WS_P) + trow * PP + hb;
    const bf16x8 xf0 = fr_row(GF, 16 * ta_, 0, ln_), xf1 = fr_row(GF, 16 * ta_, 1, ln_), xr0 = fr_row(GR, 16 * ta_, 0, ln_), xr1 = fr_row(GR, 16 * ta_, 1, ln_);
    f32x4 y[4]; float s1 = 0.f;
#pragma unroll
    for (int tb = 0; tb < 4; ++tb) { const int b0_ = 16 * tb + bq; const u32x2 hv = *(const u32x2*)(Hb + b0_);
        f32x4 acc = {bf2f(hv.x & 0xffffu), bf2f(hv.x >> 16), bf2f(hv.y & 0xffffu), bf2f(hv.y >> 16)};
        acc = __builtin_amdgcn_mfma_f32_16x16x32_bf16(fr_row(SF, 16 * tb, 0, ln_), xf0, acc, 0, 0, 0); acc = __builtin_amdgcn_mfma_f32_16x16x32_bf16(fr_row(SF, 16 * tb, 1, ln_), xf1, acc, 0, 0, 0);
        acc = __builtin_amdgcn_mfma_f32_16x16x32_bf16(fr_row(SRv, 16 * tb, 0, ln_), xr0, acc, 0, 0, 0); acc = __builtin_amdgcn_mfma_f32_16x16x32_bf16(fr_row(SRv, 16 * tb, 1, ln_), xr1, acc, 0, 0, 0);
        y[tb] = acc; s1 += (acc[0] + acc[1]) + (acc[2] + acc[3]); }
    s1 += __shfl_xor(s1, 16); s1 += __shfl_xor(s1, 32);
    const float mean = s1 * (1.0f / 64.0f); float s2 = 0.f;
#pragma unroll
    for (int tb = 0; tb < 4; ++tb) { y[tb] = y[tb] - mean; s2 += (y[tb][0] * y[tb][0] + y[tb][1] * y[tb][1]) + (y[tb][2] * y[tb][2] + y[tb][3] * y[tb][3]); }
    s2 += __shfl_xor(s2, 16); s2 += __shfl_xor(s2, 32);
    const float rstd = 1.0f / sqrtf(s2 * (1.0f / 64.0f) + 64e-5f);
#pragma unroll
    for (int tb = 0; tb < 4; ++tb) { const int b0_ = 16 * tb + bq;
        const f32x4 gg = *(const f32x4*)(X.a->in[IN_GNG] + hb + b0_), gb = *(const f32x4*)(X.a->in[IN_GNB] + hb + b0_);
        const u32x2 bv = *(const u32x2*)(BV + b0_), gt = *(const u32x2*)(GG + b0_);
        const f32x4 bvf = {bf2f(bv.x & 0xffffu), bf2f(bv.x >> 16), bf2f(bv.y & 0xffffu), bf2f(bv.y >> 16)}, gtf = {bf2f(gt.x & 0xffffu), bf2f(gt.x >> 16), bf2f(gt.y & 0xffffu), bf2f(gt.y >> 16)};
        const f32x4 o = (y[tb] * rstd * gg + gb + bvf) * gtf;
        stg4(O + b0_, o[0], o[1], o[2], o[3]); }
    __syncthreads();
}
__device__ __forceinline__ float ret_lg(const KCtx& X, int d, int rh) { const float x = X.a->in[IN_RDEC][d * 4 + rh]; return -(x > 20.f ? x : log1pf(__expf(x))); }
__device__ __forceinline__ int sw128(int r, int c) { return r * 128 + ((((c >> 3) ^ (r & 7))) << 3) + (c & 7); }
__device__ __forceinline__ bf16x8 fr_row128(const LAS bf16* buf, int r0, int ks, int lane) {
    const int row = r0 + (lane & 15), ch = 4 * ks + (lane >> 4);
    return *(const LAS bf16x8*)(buf + row * 128 + ((ch ^ (row & 7)) << 3));
}
__device__ __forceinline__ bf16x8 fr_tr128(const LAS bf16* buf, int c0, int ks, int lane) {
    const int g = lane >> 4, q = (lane >> 2) & 3, p = lane & 3, col = c0 + 4 * p;
    const int k0 = 32 * ks + 8 * g + q, k1 = k0 + 4;
    const s16x4 lo = __builtin_amdgcn_ds_read_tr16_b64_v4i16((LAS s16x4*)(buf + k0 * 128 + (((col >> 3) ^ (k0 & 7)) << 3) + (col & 7)));
    const s16x4 hi = __builtin_amdgcn_ds_read_tr16_b64_v4i16((LAS s16x4*)(buf + k1 * 128 + (((col >> 3) ^ (k1 & 7)) << 3) + (col & 7)));
    return (bf16x8){lo[0], lo[1], lo[2], lo[3], hi[0], hi[1], hi[2], hi[3]};
}
__device__ __forceinline__ void st8_128(LAS bf16* buf, int r, int chunk, const float (&v)[8]) {
    v4u o; o.x = pk2(v[0], v[1]); o.y = pk2(v[2], v[3]); o.z = pk2(v[4], v[5]); o.w = pk2(v[6], v[7]);
    *(LAS v4u*)(buf + r * 128 + ((chunk ^ (r & 7)) << 3)) = o;
}
__device__ __forceinline__ void ret_load_qk(const KCtx& X, LAS bf16* dst, LAS bf16* dst2, const LAS float* w1, const LAS float* w2, size_t row0, int colbase, bool rope, int tpos0, float scale) {
    const bf16* Pb = (const bf16*)(X.a->ws + WS_P); const float* rp = (const float*)(X.a->ws + WS_ROPE);
    for (int it = X.tid; it < 1024; it += NTHR) {
        const int j = it >> 3, half = (it >> 2) & 1, pc = it & 3;
        const bf16* p = Pb + (row0 + j) * PP + colbase + half * 64 + pc * 8;
        const v4u a = *(const v4u*)p, b2 = *(const v4u*)(p + 32);
        const unsigned aw[4] = {a.x, a.y, a.z, a.w}, bw[4] = {b2.x, b2.y, b2.z, b2.w};
        float z1[8], z2[8];
#pragma unroll
        for (int w = 0; w < 4; ++w) { z1[2 * w] = bf2f(aw[w] & 0xffffu); z1[2 * w + 1] = bf2f(aw[w] >> 16); z2[2 * w] = bf2f(bw[w] & 0xffffu); z2[2 * w + 1] = bf2f(bw[w] >> 16); }
        float o1[8], o2[8];
        if (rope) { const int tp = tpos0 + j; const int pos = half ? (tp & 63) : (tp >> 6);
#pragma unroll
            for (int e = 0; e < 8; ++e) { const float cs = rp[(pos * 32 + pc * 8 + e) * 2], sn = rp[(pos * 32 + pc * 8 + e) * 2 + 1];
                o1[e] = (z1[e] * cs - z2[e] * sn) * scale; o2[e] = (z1[e] * sn + z2[e] * cs) * scale; } }
        else {
#pragma unroll
            for (int e = 0; e < 8; ++e) { o1[e] = z1[e] * scale; o2[e] = z2[e] * scale; } }
        const int ch1 = half * 8 + pc, ch2 = ch1 + 4;
        if (dst2 == nullptr) { st8_128(dst, j, ch1, o1); st8_128(dst, j, ch2, o2); }
        else { const float wa = w1[j], wb = w2[j]; float t1[8], t2[8];
#pragma unroll
            for (int e = 0; e < 8; ++e) { t1[e] = o1[e] * wa; t2[e] = o2[e] * wa; }
            st8_128(dst, j, ch1, t1); st8_128(dst, j, ch2, t2);
#pragma unroll
            for (int e = 0; e < 8; ++e) { t1[e] = o1[e] * wb; t2[e] = o2[e] * wb; }
            st8_128(dst2, j, ch1, t1); st8_128(dst2, j, ch2, t2); }
    }
}
__device__ __forceinline__ void ret_load_plain(const KCtx& X, LAS bf16* dst, const bf16* src, size_t pitch) {
    for (int it = X.tid; it < 2048; it += NTHR) { const int j = it >> 4, pc = it & 15; *(LAS v4u*)(dst + j * 128 + ((pc ^ (j & 7)) << 3)) = *(const v4u*)(src + (size_t)j * pitch + pc * 8); }
}
__device__ __forceinline__ void ret_u_unit(const KCtx& X, int unit) {
    const int ci = unit % RCH, bh = unit / RCH, b = bh >> 2, rh = bh & 3;
    const bool isctx = ci < 2; const int n = isctx ? ci : ci - 2;
    const size_t row0 = isctx ? (size_t)(MLAT + b * CTX + n * 128) : (size_t)(b * T + n * 128);
    LAS bf16* KF = (LAS bf16*)X.lds; LAS bf16* KR = KF + 16384; LAS bf16* V = KR + 16384;
    LAS float* WF = (LAS float*)(X.lds + 98304); LAS float* WR = WF + 128;
    const float lg0 = ret_lg(X, 0, rh), lg1 = ret_lg(X, 1, rh);
    if (X.tid < 128) { WF[X.tid] = __expf(lg0 * (float)(127 - X.tid)); WR[X.tid] = __expf(lg1 * (float)X.tid); }
    __syncthreads();
    ret_load_qk(X, KF, KR, WF, WR, row0, C_RK + rh * 128, !isctx, n * 128, 0.08838834764831845f);
    ret_load_plain(X, V, (const bf16*)(X.a->ws + WS_P) + row0 * PP + C_RV + rh * 128, PP);
    __syncthreads();
    const int sf = ci, sr = isctx ? 1 - ci : 2 + 63 - n;
    bf16* Uf = (bf16*)(X.a->ws + WS_RET) + (((size_t)(b * 4 + rh) * 2 + 0) * RCH + sf) * 16384;
    bf16* Ur = (bf16*)(X.a->ws + WS_RET) + (((size_t)(b * 4 + rh) * 2 + 1) * RCH + sr) * 16384;
    int ln_ = X.lane; asm volatile("" : "+v"(ln_));
    const int a0 = 16 * X.wave, a_ = a0 + (ln_ & 15), bq = 4 * (ln_ >> 4);
#pragma unroll
    for (int dir = 0; dir < 2; ++dir) { const LAS bf16* KW = dir ? KR : KF; bf16* U = dir ? Ur : Uf;
        bf16x8 xk[4];
#pragma unroll
        for (int ks = 0; ks < 4; ++ks) xk[ks] = fr_tr128(KW, a0, ks, ln_);
#pragma unroll 2
        for (int tb = 0; tb < 8; ++tb) { f32x4 acc = {0.f, 0.f, 0.f, 0.f};
#pragma unroll
            for (int ks = 0; ks < 4; ++ks) acc = __builtin_amdgcn_mfma_f32_16x16x32_bf16(fr_tr128(V, 16 * tb, ks, ln_), xk[ks], acc, 0, 0, 0);
            stg4(U + a_ * 128 + 16 * tb + bq, acc[0], acc[1], acc[2], acc[3]); } }
    __syncthreads();
}
__device__ __forceinline__ void ret_prefix(const KCtx& X, int worker, int nworkers) {
    unsigned* R = (unsigned*)(X.a->ws + WS_RET);
    for (int p = worker * NTHR + X.tid; p < 16 * 8192; p += nworkers * NTHR) {
        const int c = p >> 13, e = p & 8191, d = c & 1, rh = (c >> 1) & 3;
        const float g = __expf(ret_lg(X, d, rh) * 128.0f);
        unsigned* q = R + (size_t)c * RCH * 8192 + e; float s0 = 0.f, s1 = 0.f;
#pragma unroll 2
        for (int s = 0; s < RCH; ++s) { const unsigned u = q[(size_t)s * 8192]; q[(size_t)s * 8192] = pk2(s0, s1); s0 = s0 * g + bf2f(u & 0xffffu); s1 = s1 * g + bf2f(u >> 16); }
    }
}
__device__ __forceinline__ void ret_out_unit(const KCtx& X, int unit) {
    const int n = unit & 63, bh = unit >> 6, b = bh >> 2, rh = bh & 3;
    const size_t row0 = (size_t)(b * T + n * 128);
    LAS bf16* Q = (LAS bf16*)X.lds; LAS bf16* K = Q + 16384; LAS bf16* V = K + 16384; LAS bf16* SC = V + 16384;
    const float lg0 = ret_lg(X, 0, rh), lg1 = ret_lg(X, 1, rh);
    ret_load_qk(X, Q, nullptr, nullptr, nullptr, row0, C_RQ + rh * 128, true, n * 128, 1.0f);
    ret_load_qk(X, K, nullptr, nullptr, nullptr, row0, C_RK + rh * 128, true, n * 128, 0.08838834764831845f);
    ret_load_plain(X, V, (const bf16*)(X.a->ws + WS_P) + row0 * PP + C_RV + rh * 128, PP);
    __syncthreads();
    int ln_ = X.lane; asm volatile("" : "+v"(ln_));
    const int a0 = 16 * X.wave, a_ = a0 + (ln_ & 15), bq = 4 * (ln_ >> 4);
    bf16x8 xq[4];
#pragma unroll
    for (int ks = 0; ks < 4; ++ks) xq[ks] = fr_row128(Q, a0, ks, ln_);
#pragma unroll 2
    for (int tb = 0; tb < 8; ++tb) { f32x4 acc = {0.f, 0.f, 0.f, 0.f};
#pragma unroll
        for (int ks = 0; ks < 4; ++ks) acc = __builtin_amdgcn_mfma_f32_16x16x32_bf16(fr_row128(K, 16 * tb, ks, ln_), xq[ks], acc, 0, 0, 0);
        float o[4];
#pragma unroll
        for (int i = 0; i < 4; ++i) { const int j = 16 * tb + bq + i; o[i] = acc[i] * (j <= a_ ? __expf(lg0 * (float)(a_ - j)) : __expf(lg1 * (float)(j - a_))); }
        u32x2 w; w.x = pk2(o[0], o[1]); w.y = pk2(o[2], o[3]); *(LAS u32x2*)(SC + sw128(a_, 16 * tb + bq)) = w; }
    __syncthreads();
    const bf16* Sf = (const bf16*)(X.a->ws + WS_RET) + (((size_t)(b * 4 + rh) * 2 + 0) * RCH + (2 + n)) * 16384;
    const bf16* Sr = (const bf16*)(X.a->ws + WS_RET) + (((size_t)(b * 4 + rh) * 2 + 1) * RCH + (2 + 63 - n)) * 16384;
    f32x4 y[8];
    { bf16x8 xs[4];
#pragma unroll
      for (int ks = 0; ks < 4; ++ks) xs[ks] = fr_row128(SC, a0, ks, ln_);
#pragma unroll
      for (int tb = 0; tb < 8; ++tb) { f32x4 acc = {0.f, 0.f, 0.f, 0.f};
#pragma unroll
          for (int ks = 0; ks < 4; ++ks) acc = __builtin_amdgcn_mfma_f32_16x16x32_bf16(fr_tr128(V, 16 * tb, ks, ln_), xs[ks], acc, 0, 0, 0);
          y[tb] = acc; } }
#pragma unroll 1
    for (int dir = 0; dir < 2; ++dir) {
        ret_load_plain(X, K, dir ? Sr : Sf, 128);
        __syncthreads();
        const float cc = dir ? __expf(lg1 * (float)(128 - a_)) : __expf(lg0 * (float)(a_ + 1));
#pragma unroll
        for (int tb = 0; tb < 8; ++tb) { f32x4 acc = {0.f, 0.f, 0.f, 0.f};
#pragma unroll
            for (int ks = 0; ks < 4; ++ks) acc = __builtin_amdgcn_mfma_f32_16x16x32_bf16(fr_tr128(K, 16 * tb, ks, ln_), xq[ks], acc, 0, 0, 0);
            y[tb] = y[tb] + acc * cc; }
        __syncthreads();
    }
    float s1 = 0.f;
#pragma unroll
    for (int tb = 0; tb < 8; ++tb) s1 += (y[tb][0] + y[tb][1]) + (y[tb][2] + y[tb][3]);
    s1 += __shfl_xor(s1, 16); s1 += __shfl_xor(s1, 32);
    const float mean = s1 * (1.0f / 128.0f); float s2 = 0.f;
#pragma unroll
    for (int tb = 0; tb < 8; ++tb) { y[tb] = y[tb] - mean; s2 += (y[tb][0] * y[tb][0] + y[tb][1] * y[tb][1]) + (y[tb][2] * y[tb][2] + y[tb][3] * y[tb][3]); }
    s2 += __shfl_xor(s2, 16); s2 += __shfl_xor(s2, 32);
    const float rstd = 1.0f / sqrtf(s2 * (1.0f / 128.0f) + 1e-5f);
    const bf16* Pb = (const bf16*)(X.a->ws + WS_P) + (row0 + a_) * PP;
    bf16* O = (bf16*)(X.a->ws + WS_P) + (row0 + a_) * PP + 512 + rh * 128;
#pragma unroll
    for (int tb = 0; tb < 8; ++tb) { const int c = rh * 128 + 16 * tb + bq;
        const f32x4 gg = *(const f32x4*)(X.a->in[IN_RGNG] + c), gb = *(const f32x4*)(X.a->in[IN_RGNB] + c);
        const u32x2 gw = *(const u32x2*)(Pb + C_RG + c);
        const f32x4 gt = {bf2f(gw.x & 0xffffu), bf2f(gw.x >> 16), bf2f(gw.y & 0xffffu), bf2f(gw.y >> 16)};
        f32x4 o = y[tb] * rstd * gg + gb;
#pragma unroll
        for (int i = 0; i < 4; ++i) o[i] = o[i] * gt[i] * sigm(gt[i]);
        stg4(O + 16 * tb + bq, o[0], o[1], o[2], o[3]); }
    __syncthreads();
}
__device__ __forceinline__ void moe_convert(const KCtx& X) {
    LAS float* scr = (LAS float*)(X.lds + X.wave * 8704);
    const int gw = X.vcu * NWAVES + X.wave, NGW = X.G * NWAVES;
    bf16* WguT = (bf16*)(X.a->ws + WS_WGU); bf16* WdT = (bf16*)(X.a->ws + WS_WD);
    constexpr int IGU = 16 * 16, IDN = 8 * 32;
    for (int it = gw; it < 32 * (2 * IGU + IDN); it += NGW) {
        const int e = it / (2 * IGU + IDN); int r = it % (2 * IGU + IDN);
        if (r < 2 * IGU) { const int up = r >= IGU; if (up) r -= IGU; const int nb = r % 16, n0 = nb * 32, pnl = n0 >> 7;
            transpose_item((up ? X.a->in[IN_EWU] : X.a->in[IN_EWG]) + (size_t)e * 1024 * 512, 1024, 512, WguT, e * 1024 + pnl * 128 + up * 128, scr, r, X.lane); }
        else { r -= 2 * IGU; transpose_item(X.a->in[IN_EWD] + (size_t)e * 512 * 1024, 512, 1024, WdT, e * 1024, scr, r, X.lane); }
    }
}
__device__ __forceinline__ void moe_route(const KCtx& X) {
    const float* mod = (const float*)(X.a->ws + WS_MOD); const float* RTt = (const float*)(X.a->ws + WS_RT);
    bf16* U2 = (bf16*)(X.a->ws + WS_U2);
    int* toke = (int*)(X.a->ws + WS_ROUTE + RT_TOKE); int* tokpos = (int*)(X.a->ws + WS_ROUTE + RT_TOKPOS); float* tokgate = (float*)(X.a->ws + WS_ROUTE + RT_TOKGATE);
    unsigned* cnt = (unsigned*)(X.a->ws + WS_CTL) + CW_CNT;
    const int gw = X.vcu * NWAVES + X.wave, NGW = X.G * NWAVES;
    for (int m = gw; m < MLAT; m += NGW) {
        float* zr = X.a->out + (size_t)m * D; const float* mr = mod + (m >> 13) * 6144;
        f32x4 v[4]; float s = 0.f;
#pragma unroll
        for (int j = 0; j < 4; ++j) { v[j] = *(const f32x4*)(zr + 4 * X.lane + 256 * j); s += (v[j].x + v[j].y) + (v[j].z + v[j].w); }
        const float mean = wave_sum(s) * (1.f / D); float s2 = 0.f;
#pragma unroll
        for (int j = 0; j < 4; ++j) { v[j] = v[j] - mean; s2 += (v[j].x * v[j].x + v[j].y * v[j].y) + (v[j].z * v[j].z + v[j].w * v[j].w); }
        const float rstd = 1.f / sqrtf(wave_sum(s2) * (1.f / D) + LN_EPS);
        f32x4 u[4];
#pragma unroll
        for (int j = 0; j < 4; ++j) { const int c = 4 * X.lane + 256 * j;
            const f32x4 g = *(const f32x4*)(X.a->in[IN_LN1G] + c), bb = *(const f32x4*)(X.a->in[IN_LN1B] + c), sh = *(const f32x4*)(mr + 3072 + c), sc = *(const f32x4*)(mr + 4096 + c);
            const f32x4 h = v[j] * rstd * g + bb; *(f32x4*)(zr + c) = h; u[j] = h * (sc + 1.0f) + sh;
            *(unsigned long long*)(U2 + (size_t)m * D + c) = (unsigned long long)pk2(u[j].x, u[j].y) | ((unsigned long long)pk2(u[j].z, u[j].w) << 32); }
        float gl[4]; float gmax = -3.0e38f; int gi = 0;
#pragma unroll
        for (int g = 0; g < 4; ++g) { float p = 0.f;
#pragma unroll
            for (int j = 0; j < 4; ++j) { const f32x4 w = *(const f32x4*)(RTt + g * 1024 + 4 * X.lane + 256 * j); p += (u[j].x * w.x + u[j].y * w.y) + (u[j].z * w.z + u[j].w * w.w); }
            gl[g] = wave_sum(p) + X.a->in[IN_RGB][g]; if (gl[g] > gmax) { gmax = gl[g]; gi = g; } }
        float gsum = 0.f;
#pragma unroll
        for (int g = 0; g < 4; ++g) gsum += __expf(gl[g] - gmax);
        const float gw_ = 1.0f / gsum;
        gi = __builtin_amdgcn_readfirstlane(gi);
        float m1 = -3.0e38f, m2 = -3.0e38f; int i1 = 0, i2 = 0;
        const float* rte = RTt + (size_t)(4 + gi * 8) * 1024;
#pragma unroll 1
        for (int i = 0; i < 8; ++i) { float p = 0.f;
#pragma unroll
            for (int j = 0; j < 4; ++j) { const f32x4 w = *(const f32x4*)(rte + i * 1024 + 4 * X.lane + 256 * j); p += (u[j].x * w.x + u[j].y * w.y) + (u[j].z * w.z + u[j].w * w.w); }
            const float l = wave_sum(p) + X.a->in[IN_REB][gi * 8 + i];
            if (l > m1) { m2 = m1; i2 = i1; m1 = l; i1 = i; } else if (l > m2) { m2 = l; i2 = i; } }
        const float e2 = __expf(m2 - m1); const float ga = gw_ / (1.0f + e2), gb = gw_ * e2 / (1.0f + e2);
        if (X.lane == 0) { const int ea = gi * 8 + i1, eb = gi * 8 + i2;
            const unsigned pa = atomicAdd(cnt + ea, 1u), pb = atomicAdd(cnt + eb, 1u);
            toke[2 * m] = ea; toke[2 * m + 1] = eb; tokpos[2 * m] = (int)pa; tokpos[2 * m + 1] = (int)pb; tokgate[2 * m] = ga; tokgate[2 * m + 1] = gb; }
    }
}
__device__ __forceinline__ int moe_tiles(const KCtx& X, LAS int* tile_e, LAS int* pstart) {
    const unsigned* cnt = (const unsigned*)(X.a->ws + WS_CTL) + CW_CNT;
    if (X.tid == 0) { int acc = 0; for (int e = 0; e < 32; ++e) { const int c = (int)__hip_atomic_load(cnt + e, RLX_AGENT); const int nt = (c + 255) >> 8; pstart[e] = acc * 256; for (int t = 0; t < nt; ++t) tile_e[acc + t] = e; acc += nt; } pstart[32] = acc; }
    __syncthreads();
    return pstart[32];
}
__device__ __forceinline__ void moe_gather(const KCtx& X) {
    LAS int* tile_e = (LAS int*)(X.lds + L_MISC); LAS int* pstart = tile_e + 256;
    (void)moe_tiles(X, tile_e, pstart);
    const bf16* U2 = (const bf16*)(X.a->ws + WS_U2); bf16* Xs = (bf16*)(X.a->ws + WS_XS);
    const int* toke = (const int*)(X.a->ws + WS_ROUTE + RT_TOKE); const int* tokpos = (const int*)(X.a->ws + WS_ROUTE + RT_TOKPOS); const float* tokgate = (const float*)(X.a->ws + WS_ROUTE + RT_TOKGATE);
    int* tokslot = (int*)(X.a->ws + WS_ROUTE + RT_TOKSLOT); float* sgate = (float*)(X.a->ws + WS_ROUTE + RT_SGATE);
    const int gw = X.vcu * NWAVES + X.wave, NGW = X.G * NWAVES;
    for (int m = gw; m < MLAT; m += NGW) {
        const v4u a = *(const v4u*)(U2 + (size_t)m * D + 8 * X.lane), b2 = *(const v4u*)(U2 + (size_t)m * D + 512 + 8 * X.lane);
#pragma unroll
        for (int k = 0; k < 2; ++k) { const int slot = pstart[toke[2 * m + k]] + tokpos[2 * m + k];
            *(v4u*)(Xs + (size_t)slot * D + 8 * X.lane) = a; *(v4u*)(Xs + (size_t)slot * D + 512 + 8 * X.lane) = b2;
            if (X.lane == 0) { tokslot[2 * m + k] = slot; sgate[slot] = tokgate[2 * m + k]; } }
    }
}
__device__ __forceinline__ void moe_final(const KCtx& X) {
    const float* mod = (const float*)(X.a->ws + WS_MOD); const bf16* Ys = (const bf16*)(X.a->ws + WS_XS); const int* tokslot = (const int*)(X.a->ws + WS_ROUTE + RT_TOKSLOT);
    const int gw = X.vcu * NWAVES + X.wave, NGW = X.G * NWAVES;
    for (int m = gw; m < MLAT; m += NGW) {
        float* hr = X.a->out + (size_t)m * D; const float* g2 = mod + (m >> 13) * 6144 + 5120;
        const bf16* y0 = Ys + (size_t)tokslot[2 * m] * D; const bf16* y1 = Ys + (size_t)tokslot[2 * m + 1] * D;
        f32x4 v[4]; float s = 0.f;
#pragma unroll
        for (int j = 0; j < 4; ++j) { const int c = 4 * X.lane + 256 * j; const f32x4 h = *(const f32x4*)(hr + c), gg = *(const f32x4*)(g2 + c);
            const unsigned long long a = *(const unsigned long long*)(y0 + c), b2 = *(const unsigned long long*)(y1 + c);
            f32x4 f; f.x = bf2f((unsigned)a & 0xffffu) + bf2f((unsigned)b2 & 0xffffu); f.y = bf2f(((unsigned)a) >> 16) + bf2f(((unsigned)b2) >> 16);
            f.z = bf2f((unsigned)(a >> 32) & 0xffffu) + bf2f((unsigned)(b2 >> 32) & 0xffffu); f.w = bf2f((unsigned)(a >> 48)) + bf2f((unsigned)(b2 >> 48));
            v[j] = h * ALPHA + gg * f; s += (v[j].x + v[j].y) + (v[j].z + v[j].w); }
        const float mean = wave_sum(s) * (1.f / D); float s2 = 0.f;
#pragma unroll
        for (int j = 0; j < 4; ++j) { v[j] = v[j] - mean; s2 += (v[j].x * v[j].x + v[j].y * v[j].y) + (v[j].z * v[j].z + v[j].w * v[j].w); }
        const float rstd = 1.f / sqrtf(wave_sum(s2) * (1.f / D) + LN_EPS);
#pragma unroll
        for (int j = 0; j < 4; ++j) { const int c = 4 * X.lane + 256 * j; const f32x4 g = *(const f32x4*)(X.a->in[IN_LN2G] + c), bb = *(const f32x4*)(X.a->in[IN_LN2B] + c);
            *(f32x4*)(hr + c) = v[j] * rstd * g + bb; }
    }
}
__global__ void __launch_bounds__(NTHR, 2) fwd_kernel(Args args) {
    extern __shared__ __attribute__((aligned(16))) unsigned char lds_raw[];
    KCtx X;
    X.lds = (LAS unsigned char*)lds_raw;
    X.tid = threadIdx.x; X.lane = X.tid & 63; X.wave = __builtin_amdgcn_readfirstlane(X.tid >> 6);
    X.G = gridDim.x; { const int bx = blockIdx.x; X.vcu = (X.G % 8 == 0) ? (bx % 8) * (X.G / 8) + bx / 8 : bx; }
    X.a = &args;
    volatile LAS unsigned* CTLW = (volatile LAS unsigned*)(X.lds + L_CTL);
    for (int u = X.tid; u < 128; u += NTHR) CTLW[u] = 0u;
    __syncthreads();
    XcdBarrier bar; bar.bar = (unsigned*)(X.a->ws + WS_CTL) + CW_BAR; bar.x = 0; bar.st = nullptr;
    if (N_LAUNCHES == 1) bar = xcd_barrier_post((unsigned*)(X.a->ws + WS_CTL) + CW_BAR, CTLW + 8);
    const int lo = args.ph_lo, hi = args.ph_hi;
#ifndef PHMASK
#define PHMASK 0xFFF
#endif
#define IN(k) (((PHMASK >> (k)) & 1) && lo <= (k) && (k) < hi)
#define SEAM(k) do { if (IN(k) && IN((k) + 1)) xcd_barrier(bar); } while (0)

    if (IN(0)) { phase0(X); } SEAM(0);
    if (IN(1)) { phase1(X); } SEAM(1);
    if (IN(2)) {
        pg8::Gemm g{(const bf16*)(X.a->ws + WS_U), (const bf16*)(X.a->ws + WS_WIN), MALL, PP, D, D}; pg8::StaticOrder S; S.init(MALL, PP, X.G, (int)blockIdx.x);
        pg8::EpiBf16 E{(bf16*)(X.a->ws + WS_P), PP};
        pg8::gemm_phase<pg8::EpiBf16, pg8::StaticOrder, true, true>(X.lds, g, S, E);
    } SEAM(2);
    if (IN(3)) {
        for (int u = X.vcu; u < 16 * NCHUNK + 8 * RCH; u += X.G) { if (u < 16 * NCHUNK) rwkv_unit(X, u); else ret_u_unit(X, u - 16 * NCHUNK); }
    } SEAM(3);
    if (IN(4)) {
        if (X.G >= 64) { if (X.vcu < 32) rwkv_scan(X, X.vcu); else ret_prefix(X, X.vcu - 32, X.G - 32); }
        else { for (int c = X.vcu; c < 32; c += X.G) rwkv_scan(X, c); ret_prefix(X, X.vcu, X.G); }
    } SEAM(4);
    if (IN(5)) {
        for (int u = X.vcu; u < 1024 + 512; u += X.G) { if (u < 512) ret_out_unit(X, u); else rwkv_out_pair(X, u - 512); }
    } SEAM(5);
    if (IN(6)) {
        pg8::Gemm g{(const bf16*)(X.a->ws + WS_P), (const bf16*)(X.a->ws + WS_WOUT), MLAT, D, D, PP}; pg8::StaticOrder S; S.init(MLAT, D, X.G, (int)blockIdx.x);
        pg8::EpiOut E{X.a->in[IN_X], (const float*)(X.a->ws + WS_STATS), X.a->in[IN_EG], X.a->in[IN_EB], (const float*)(X.a->ws + WS_MOD), X.a->out, ALPHA};
        pg8::gemm_phase<pg8::EpiOut, pg8::StaticOrder, true, true>(X.lds, g, S, E);
    } SEAM(6);
    if (IN(7)) { moe_convert(X); moe_route(X); } SEAM(7);
    if (IN(8)) { moe_gather(X); } SEAM(8);
    if (IN(9)) {
        LAS int* tile_e = (LAS int*)(X.lds + L_MISC); LAS int* pstart = tile_e + 256;
        const int ntiles = moe_tiles(X, tile_e, pstart);
        pg8::Gemm g{(const bf16*)(X.a->ws + WS_XS), (const bf16*)(X.a->ws + WS_WGU), ntiles * 256, 1024, D, D};
        pg8::MoeOrder S; S.base.init(ntiles * 256, 1024, X.G, (int)blockIdx.x); S.tile_e = tile_e;
        pg8::EpiGU E{(bf16*)(X.a->ws + WS_HS)};
        pg8::gemm_phase<pg8::EpiGU, pg8::MoeOrder, true, true>(X.lds, g, S, E);
    } SEAM(9);
    if (IN(10)) {
        LAS int* tile_e = (LAS int*)(X.lds + L_MISC); LAS int* pstart = tile_e + 256;
        const int ntiles = moe_tiles(X, tile_e, pstart);
        pg8::Gemm g{(const bf16*)(X.a->ws + WS_HS), (const bf16*)(X.a->ws + WS_WD), ntiles * 256, 1024, 512, 512};
        pg8::MoeOrder S; S.base.init(ntiles * 256, 1024, X.G, (int)blockIdx.x); S.tile_e = tile_e;
        pg8::EpiDown E{(bf16*)(X.a->ws + WS_XS), (const float*)(X.a->ws + WS_ROUTE + RT_SGATE)};
        pg8::gemm_phase<pg8::EpiDown, pg8::MoeOrder, true, true>(X.lds, g, S, E);
    } SEAM(10);
    if (IN(11)) { moe_final(X); }
#undef IN
#undef SEAM
}

extern "C" void kernel_launch(void* const* d_in, const int* in_sizes, int n_in, void* d_out, int out_size, void* d_ws, size_t ws_size, hipStream_t stream) {
    static int grid = 0;
    if (grid == 0) {
        if (n_in != 35 || out_size != MLAT * D || ws_size < WS_NEED) { fprintf(stderr, "kernel_launch: unexpected problem (n_in %d, out %d, ws %zu < %zu)\n", n_in, out_size, ws_size, (size_t)WS_NEED); grid = -1; return; }
        int dev = 0, cus = 0;
        if (hipGetDevice(&dev) != hipSuccess || hipDeviceGetAttribute(&cus, hipDeviceAttributeMultiprocessorCount, dev) != hipSuccess) { grid = -1; return; }
        if (hipFuncSetAttribute((const void*)fwd_kernel, hipFuncAttributeMaxDynamicSharedMemorySize, LDS_BYTES) != hipSuccess) { fprintf(stderr, "kernel_launch: hipFuncSetAttribute failed\n"); grid = -1; return; }
        (void)hipGetLastError();
        grid = cus;
    }
    if (grid < 0) return;
    if (hipMemsetAsync((char*)d_ws + WS_CTL, 0, CTL_ZERO_BYTES, stream) != hipSuccess) return;
    Args a{};
    for (int i = 0; i < 35; ++i) a.in[i] = (const float*)d_in[i];
    a.out = (float*)d_out; a.ws = (unsigned char*)d_ws;
    if (N_LAUNCHES == 1) { a.ph_lo = 0; a.ph_hi = NPHASE; hipLaunchKernelGGL(fwd_kernel, dim3(grid), dim3(NTHR), LDS_BYTES, stream, a); }
    else for (int p = 0; p < NPHASE; ++p) { a.ph_lo = p; a.ph_hi = p + 1; hipLaunchKernelGGL(fwd_kernel, dim3(grid), dim3(NTHR), LDS_BYTES, stream, a); }
}
```

```cpp
#include <hip/hip_runtime.h>
#include <cstdio>
#include <cstdint>
namespace pg8 {
#define PG8_LAS __attribute__((address_space(3)))
typedef unsigned short bf16_t;
typedef short bf16x8 __attribute__((ext_vector_type(8)));
typedef float f32x4 __attribute__((ext_vector_type(4)));
typedef unsigned u32x4 __attribute__((ext_vector_type(4)));
constexpr int BM = 256, BK = 64, HALF = 128, HTB = HALF * BK * 2  , STAGE_BYTES = 8 * HTB, NXCD = 8, WGM = 8;

__host__ __device__ __forceinline__ int lds_byte(int r, int c) { const int st = (r >> 4) * 2 + (c >> 5), rr = r & 15, cc = c & 31, ob = rr * 64 + cc * 2; return st * 1024 + (ob ^ (((ob >> 9) & 1) << 5)); }
__host__ __device__ __forceinline__ void stage_rc(int b, int& R, int& C) { const int st = b / 1024, sb = b % 1024, swz = sb ^ (((sb >> 9) & 1) << 5); R = (st >> 1) * 16 + swz / 64; C = (st & 1) * 32 + (swz % 64) / 2; }
__host__ __device__ __forceinline__ int perm32(int rho) { const int n = rho >> 4, i = rho & 15; return 8 * (i >> 2) + 4 * n + (i & 3); }

struct Unit { int pm, pn; };
struct Gemm { const bf16_t* A; const bf16_t* Bt; int M, N, K, lda; };

struct StaticOrder {
    int nM, nN, nwg, G, c;
    __host__ __device__ void init(int M, int N, int G_, int c_) { nM = M / BM; nN = N / BM; nwg = nM * nN; G = G_; c = c_; }
    __host__ __device__ bool next(int i, Unit& u) const {
        const long L = (long)i * G + c; if (L >= nwg) return false;
        int wgid = (int)L; { const int q = nwg / NXCD, r = nwg % NXCD, xcd = wgid % NXCD, off = wgid / NXCD; wgid = (xcd < r ? xcd * (q + 1) : r * (q + 1) + (xcd - r) * q) + off; }
        const int nig = WGM * nN, gid = wgid / nig, fm = gid * WGM, gsz = (nM - fm) < WGM ? (nM - fm) : WGM;
        u.pm = fm + ((wgid % nig) % gsz); u.pn = (wgid % nig) / gsz; return true;
    }
    __device__ __forceinline__ void a_ready(const Unit&) const {}
    __device__ __forceinline__ void done(const Unit&) const {}
};

__device__ __forceinline__ unsigned cvt_pk_bf16(float lo, float hi) { unsigned r; asm volatile("v_cvt_pk_bf16_f32 %0, %1, %2" : "=v"(r) : "v"(lo), "v"(hi)); return r; }
typedef float f32x2 __attribute__((ext_vector_type(2)));
struct EpiBf16 {
    static constexpr bool PERM = true, AFTER_DRAIN = false;
    bf16_t* O; int ldc;
    __device__ __forceinline__ void operator()(const f32x4 (&acc)[2][2][4][2], const Unit& u, int wr, int wc, int fr, int fq) const {
        const int row0 = u.pm * BM + wr * 64 + fr; const int col0 = u.pn * BM + wc * 32 + 8 * fq;
#pragma unroll
        for (int ai = 0; ai < 2; ++ai)
#pragma unroll
            for (int m = 0; m < 4; ++m) { bf16_t* rowp = O + (size_t)(row0 + ai * HALF + m * 16) * ldc + col0;
#pragma unroll
                for (int bj = 0; bj < 2; ++bj) { const f32x4 v0 = acc[ai][bj][m][0], v1 = acc[ai][bj][m][1];
                    u32x4 w; w.x = cvt_pk_bf16(v0[0], v0[1]); w.y = cvt_pk_bf16(v0[2], v0[3]); w.z = cvt_pk_bf16(v1[0], v1[1]); w.w = cvt_pk_bf16(v1[2], v1[3]);
                    *(u32x4*)(rowp + bj * HALF) = w; } }
    }
};
struct EpiOut {
    static constexpr bool PERM = false, AFTER_DRAIN = false;
    const float* x; const float* stats; const float* eg; const float* eb; const float* mod; float* Z; float alpha;
    __device__ __forceinline__ void operator()(const f32x4 (&acc)[2][2][4][2], const Unit& u, int wr, int wc, int fr, int fq) const {
        const int col0 = u.pn * BM + wc * 32 + 4 * fq;
        const int b = (u.pm * BM) >> 13;
        const float* g1 = mod + (size_t)b * 6144 + 2048;
#pragma unroll
        for (int bj = 0; bj < 2; ++bj)
#pragma unroll
            for (int n = 0; n < 2; ++n) { const int c = col0 + bj * HALF + n * 16;
                const f32x4 vg = *(const f32x4*)(eg + c), vb = *(const f32x4*)(eb + c), v1 = *(const f32x4*)(g1 + c);
#pragma unroll
                for (int ai = 0; ai < 2; ++ai)
#pragma unroll
                    for (int m = 0; m < 4; ++m) { const int r = u.pm * BM + ai * HALF + wr * 64 + m * 16 + fr;
                        const float mean = stats[2 * r], rstd = stats[2 * r + 1];
                        const f32x4 xv = *(const f32x4*)(x + (size_t)r * 1024 + c);
                        f32x4 o = ((xv - mean) * rstd * vg + vb) * alpha + v1 * acc[ai][bj][m][n];
                        *(f32x4*)(Z + (size_t)r * 1024 + c) = o; } }
    }
};
struct EpiGU {
    static constexpr bool PERM = true, AFTER_DRAIN = false;
    bf16_t* Hs;
    __device__ __forceinline__ void operator()(const f32x4 (&acc)[2][2][4][2], const Unit& u, int wr, int wc, int fr, int fq) const {
        const int row0 = u.pm * BM + wr * 64 + fr; const int col0 = (u.pn & 3) * 128 + wc * 32 + 8 * fq;
#pragma unroll
        for (int ai = 0; ai < 2; ++ai)
#pragma unroll
            for (int m = 0; m < 4; ++m) { bf16_t* rowp = Hs + (size_t)(row0 + ai * HALF + m * 16) * 512 + col0;
                float h[8];
#pragma unroll
                for (int n = 0; n < 2; ++n)
#pragma unroll
                    for (int j = 0; j < 4; ++j) { const float g = acc[ai][0][m][n][j], up = acc[ai][1][m][n][j]; h[n * 4 + j] = g / (1.0f + __expf(-g)) * up; }
                u32x4 w; w.x = cvt_pk_bf16(h[0], h[1]); w.y = cvt_pk_bf16(h[2], h[3]); w.z = cvt_pk_bf16(h[4], h[5]); w.w = cvt_pk_bf16(h[6], h[7]);
                *(u32x4*)rowp = w; }
    }
};
struct EpiDown {
    static constexpr bool PERM = true, AFTER_DRAIN = false;
    bf16_t* Ys; const float* sgate;
    __device__ __forceinline__ void operator()(const f32x4 (&acc)[2][2][4][2], const Unit& u, int wr, int wc, int fr, int fq) const {
        const int row0 = u.pm * BM + wr * 64 + fr; const int col0 = (u.pn & 3) * 256 + wc * 32 + 8 * fq;
#pragma unroll
        for (int ai = 0; ai < 2; ++ai)
#pragma unroll
            for (int m = 0; m < 4; ++m) { const int r = row0 + ai * HALF + m * 16; const float gt = sgate[r]; bf16_t* rowp = Ys + (size_t)r * 1024 + col0;
#pragma unroll
                for (int bj = 0; bj < 2; ++bj) { const f32x4 v0 = acc[ai][bj][m][0] * gt, v1 = acc[ai][bj][m][1] * gt;
                    u32x4 w; w.x = cvt_pk_bf16(v0[0], v0[1]); w.y = cvt_pk_bf16(v0[2], v0[3]); w.z = cvt_pk_bf16(v1[0], v1[1]); w.w = cvt_pk_bf16(v1[2], v1[3]);
                    *(u32x4*)(rowp + bj * HALF) = w; } }
    }
};
struct MoeOrder {
    StaticOrder base; const PG8_LAS int* tile_e;
    __device__ __forceinline__ bool next(int i, Unit& u) const { if (!base.next(i, u)) return false; u.pn += 4 * tile_e[u.pm]; return true; }
    __device__ __forceinline__ void a_ready(const Unit&) const {}
    __device__ __forceinline__ void done(const Unit&) const {}
};
template <class Epi, class Sched, bool ALIGN_EPI = false, bool SP2 = false>
__device__ __forceinline__ void gemm_phase(PG8_LAS unsigned char* lds, const Gemm g, const Sched& S, const Epi& E) {
    const int tid = threadIdx.x, wid = __builtin_amdgcn_readfirstlane(tid >> 6), lane = tid & 63, wr = wid >> 2, wc = wid & 3, fr = lane & 15, fq = lane >> 4;
    const int K = g.K, nt = K / BK;
    unsigned voffA[2], voffB[2];
#pragma unroll
    for (int i = 0; i < 2; ++i) { int R, C; stage_rc(tid * 16 + i * 8192, R, C); const int Rb = Epi::PERM ? ((R & ~31) + perm32(R & 31)) : R;
        voffA[i] = (unsigned)(R * g.lda + C) * 2u; voffB[i] = (unsigned)(Rb * K + C) * 2u; }
    const size_t kstep = (size_t)(BK * 2);
    const size_t hstep = (size_t)HALF * K * 2;
    const size_t tstep = 2 * hstep; const size_t hstepA = (size_t)HALF * g.lda * 2, tstepA = 2 * hstepA;
    const unsigned ldsw = (unsigned)wid * 1024u;
    const int aoff = lds_byte(wr * 64 + fr, fq * 8), boff = lds_byte(wc * 32 + fr, fq * 8);
#define PG8_SA(b, h) (((b) * 2 + (h)) * HTB)
#define PG8_SB(b, h) ((4 + (b) * 2 + (h)) * HTB)
#define PG8_STAGE(bufoff, gbase, voff) do { _Pragma("unroll") for (int _i = 0; _i < 2; ++_i) \
        __builtin_amdgcn_global_load_lds((const unsigned*)((const char*)(gbase) + (voff)[_i]), (PG8_LAS unsigned*)(lds + (bufoff) + ldsw + _i * 8192), 16, 0, 0); } while (0)
#define PG8_LDA(dst, b, h) do { _Pragma("unroll") for (int m = 0; m < 4; ++m) _Pragma("unroll") for (int k = 0; k < 2; ++k) dst[m][k] = *(const PG8_LAS bf16x8*)(lds + PG8_SA(b, h) + aoff + m * 2048 + k * 1024); } while (0)
#define PG8_LDB(dst, b, h) do { _Pragma("unroll") for (int n = 0; n < 2; ++n) _Pragma("unroll") for (int k = 0; k < 2; ++k) dst[n][k] = *(const PG8_LAS bf16x8*)(lds + PG8_SB(b, h) + boff + n * 2048 + k * 1024); } while (0)
#define PG8_MMA(ai, bj, At, Bt) do { __builtin_amdgcn_s_setprio(1); _Pragma("unroll") for (int m = 0; m < 4; ++m) _Pragma("unroll") for (int n = 0; n < 2; ++n) _Pragma("unroll") for (int k = 0; k < 2; ++k) \
        acc[ai][bj][m][n] = __builtin_amdgcn_mfma_f32_16x16x32_bf16(Bt[n][k], At[m][k], acc[ai][bj][m][n], 0, 0, 0); __builtin_amdgcn_s_setprio(0); } while (0)
#define PG8_WAIT_V(n) asm volatile("s_waitcnt vmcnt(" #n ")" ::: "memory")
#define PG8_WAIT_L(n) asm volatile("s_waitcnt lgkmcnt(" #n ")" ::: "memory")
#define PG8_BAR __builtin_amdgcn_s_barrier()
#define PG8_SCHED __builtin_amdgcn_sched_barrier(0)
    Unit cur, nxt; int ui = 0;
    if (!S.next(0, cur)) return;
    f32x4 acc[2][2][4][2];
#pragma unroll
    for (int a = 0; a < 2; ++a)
#pragma unroll
        for (int b = 0; b < 2; ++b)
#pragma unroll
            for (int m = 0; m < 4; ++m)
#pragma unroll
                for (int n = 0; n < 2; ++n) acc[a][b][m][n] = (f32x4){0.f, 0.f, 0.f, 0.f};
    bf16x8 At[4][2], B0[2][2], B1[2][2];
    const char* cA = (const char*)g.A + (size_t)cur.pm * tstepA; const char* cB = (const char*)g.Bt + (size_t)cur.pn * tstep;
    S.a_ready(cur);
    if constexpr (SP2) {
        PG8_STAGE(PG8_SB(0, 0), cB, voffB); PG8_STAGE(PG8_SB(0, 1), cB + hstep, voffB); PG8_STAGE(PG8_SA(0, 0), cA, voffA); PG8_STAGE(PG8_SA(0, 1), cA + hstepA, voffA);
        if (wr == 1) PG8_BAR;
        PG8_WAIT_V(2); PG8_BAR;
        PG8_STAGE(PG8_SB(1, 0), cB + kstep, voffB); PG8_STAGE(PG8_SA(1, 0), cA + kstep, voffA); PG8_STAGE(PG8_SB(1, 1), cB + hstep + kstep, voffB);
        PG8_WAIT_V(6); PG8_BAR;
    } else {
        PG8_STAGE(PG8_SB(0, 0), cB, voffB); PG8_STAGE(PG8_SA(0, 0), cA, voffA); PG8_STAGE(PG8_SB(0, 1), cB + hstep, voffB); PG8_STAGE(PG8_SA(0, 1), cA + hstepA, voffA);
        if (wr == 1) PG8_BAR;
        PG8_WAIT_V(4); PG8_BAR;
        PG8_STAGE(PG8_SB(1, 0), cB + kstep, voffB); PG8_STAGE(PG8_SA(1, 0), cA + kstep, voffA); PG8_STAGE(PG8_SB(1, 1), cB + hstep + kstep, voffB);
        PG8_WAIT_V(6); PG8_BAR;
    }
    for (;;) {
        const bool has_next = S.next(ui + 1, nxt);
        const char* nA = has_next ? (const char*)g.A + (size_t)nxt.pm * tstepA : cA; const char* nB = has_next ? (const char*)g.Bt + (size_t)nxt.pn * tstep : cB;
        for (int t = 0; t < nt; t += 2) {
            const bool last = (t == nt - 2);
            const char* a1 = cA + (size_t)(t + 1) * kstep;
            const char* a2 = last ? nA : cA + (size_t)(t + 2) * kstep; const char* b2 = last ? nB : cB + (size_t)(t + 2) * kstep;
            const char* a3 = a2 + kstep; const char* b3 = b2 + kstep;
            if (last && has_next) S.a_ready(nxt);
            if constexpr (SP2) {
            PG8_LDB(B0, 0, 0); PG8_LDB(B1, 0, 1); PG8_SCHED; PG8_LDA(At, 0, 0); PG8_STAGE(PG8_SA(1, 1), a1 + hstepA, voffA);
            PG8_WAIT_V(8); PG8_WAIT_L(0); PG8_BAR; PG8_MMA(0, 0, At, B0); PG8_MMA(0, 1, At, B1); PG8_BAR; PG8_SCHED;
            PG8_LDA(At, 0, 1); PG8_STAGE(PG8_SB(0, 0), b2, voffB); PG8_STAGE(PG8_SB(0, 1), b2 + hstep, voffB); PG8_STAGE(PG8_SA(0, 0), a2, voffA);
            PG8_WAIT_V(8); PG8_WAIT_L(0); PG8_BAR; PG8_MMA(1, 0, At, B0); PG8_MMA(1, 1, At, B1); PG8_BAR; PG8_SCHED;
            PG8_LDB(B0, 1, 0); PG8_LDB(B1, 1, 1); PG8_SCHED; PG8_LDA(At, 1, 0); PG8_STAGE(PG8_SA(0, 1), a2 + hstepA, voffA);
            PG8_WAIT_V(8); PG8_WAIT_L(0); PG8_BAR; PG8_MMA(0, 0, At, B0); PG8_MMA(0, 1, At, B1); PG8_BAR; PG8_SCHED;
            PG8_LDA(At, 1, 1); PG8_STAGE(PG8_SB(1, 0), b3, voffB); PG8_STAGE(PG8_SB(1, 1), b3 + hstep, voffB); PG8_STAGE(PG8_SA(1, 0), a3, voffA);
            PG8_WAIT_V(8); PG8_WAIT_L(0); PG8_BAR; PG8_MMA(1, 0, At, B0); PG8_MMA(1, 1, At, B1); PG8_BAR; PG8_SCHED;
            } else {
            PG8_LDB(B0, 0, 0); PG8_SCHED; PG8_LDA(At, 0, 0); PG8_STAGE(PG8_SA(1, 1), a1 + hstepA, voffA);
            PG8_WAIT_L(8); PG8_BAR; PG8_WAIT_L(0); PG8_MMA(0, 0, At, B0); PG8_BAR; PG8_SCHED;
            PG8_LDB(B1, 0, 1); PG8_STAGE(PG8_SB(0, 0), b2, voffB);
            PG8_BAR; PG8_WAIT_L(0); PG8_MMA(0, 1, At, B1); PG8_BAR;
            PG8_LDA(At, 0, 1); PG8_STAGE(PG8_SA(0, 0), a2, voffA);
            PG8_BAR; PG8_WAIT_L(0); PG8_MMA(1, 0, At, B0); PG8_BAR; PG8_SCHED;
            PG8_STAGE(PG8_SB(0, 1), b2 + hstep, voffB);
            PG8_WAIT_V(6); PG8_BAR; PG8_MMA(1, 1, At, B1); PG8_BAR;
            PG8_LDB(B0, 1, 0); PG8_SCHED; PG8_LDA(At, 1, 0); PG8_STAGE(PG8_SA(0, 1), a2 + hstepA, voffA);
            PG8_WAIT_L(8); PG8_BAR; PG8_WAIT_L(0); PG8_MMA(0, 0, At, B0); PG8_BAR; PG8_SCHED;
            PG8_LDB(B1, 1, 1); PG8_STAGE(PG8_SB(1, 0), b3, voffB);
            PG8_BAR; PG8_WAIT_L(0); PG8_MMA(0, 1, At, B1); PG8_BAR;
            PG8_LDA(At, 1, 1); PG8_STAGE(PG8_SA(1, 0), a3, voffA);
            PG8_BAR; PG8_WAIT_L(0); PG8_MMA(1, 0, At, B0); PG8_BAR; PG8_SCHED;
            PG8_STAGE(PG8_SB(1, 1), b3 + hstep, voffB);
            PG8_WAIT_V(6); PG8_BAR; PG8_MMA(1, 1, At, B1); PG8_BAR;
            }
        }
        if constexpr (ALIGN_EPI) { if (wr == 0) PG8_BAR; }
        if constexpr (!Epi::AFTER_DRAIN) { E(acc, cur, wr, wc, fr, fq); S.done(cur); }
        if (!has_next) break;
#pragma unroll
        for (int a = 0; a < 2; ++a)
#pragma unroll
            for (int b = 0; b < 2; ++b)
#pragma unroll
                for (int m = 0; m < 4; ++m)
#pragma unroll
                    for (int n = 0; n < 2; ++n) acc[a][b][m][n] = (f32x4){0.f, 0.f, 0.f, 0.f};
        cur = nxt; cA = nA; cB = nB; ++ui;
        if constexpr (ALIGN_EPI) { if (wr == 1) PG8_BAR; }
    }
    PG8_WAIT_V(0);
    if constexpr (!ALIGN_EPI) { if (wr == 0) PG8_BAR; }
    PG8_BAR;
    if constexpr (Epi::AFTER_DRAIN) { E.fused(acc, cur, wr, wc, fr, fq, lds, wid, lane); S.done(cur); }
#undef PG8_SA
#undef PG8_SB
#undef PG8_STAGE
#undef PG8_LDA
#undef PG8_LDB
#undef PG8_MMA
#undef PG8_WAIT_V
#undef PG8_WAIT_L
#undef PG8_BAR
#undef PG8_SCHED
}
}
constexpr int NWAVES = 8, NTHR = 512;
#ifndef MK_N_LAUNCHES
#define MK_N_LAUNCHES 1
#endif
constexpr int N_LAUNCHES = MK_N_LAUNCHES;
constexpr int NPHASE = 12;
constexpr int NB = 2, T = 8192, D = 1024, CTX = 256;
constexpr int MLAT = NB * T, MCTX = NB * CTX, MALL = MLAT + MCTX;
constexpr int NIN = 3968, PP = 4096;
constexpr int C_R = 0, C_K = 512, C_V = 1024, C_LW = 1536, C_LA = 1664, C_LG = 1792, C_RQ = 1920, C_RK = 2432, C_RV = 2944, C_RG = 3456;
constexpr int NCHUNK = 132;
constexpr int RCH = 66;
constexpr int MSLOT = 40960;
constexpr float LN_EPS = 1e-5f, ALPHA = 1.189207115002721f;

constexpr size_t MiB = 1u << 20;
constexpr size_t WS_CTL = 0, CTL_ZERO_BYTES = 1 * MiB;
constexpr size_t WS_MOD = 1 * MiB;
constexpr size_t WS_STATS = WS_MOD + 256 * 1024;
constexpr size_t WS_RT = WS_MOD + 512 * 1024;
constexpr size_t WS_ROPE = WS_MOD + 768 * 1024;
constexpr size_t WS_W2T = 2 * MiB;
constexpr size_t WS_A2T = WS_W2T + 128 * 1024;
constexpr size_t WS_G2T = WS_W2T + 256 * 1024;
constexpr size_t WS_WIN = 3 * MiB;
constexpr size_t WS_WOUT = 11 * MiB;
constexpr size_t WS_ROUTE = 13 * MiB;
constexpr size_t WS_P = 16 * MiB;
constexpr size_t WS_U = 148 * MiB;
constexpr size_t WS_PHIPSI = 148 * MiB;
constexpr size_t WS_HB = 214 * MiB;
constexpr size_t WS_RET = 230 * MiB;
constexpr size_t WS_BV = 263 * MiB;
constexpr size_t WS_GG = 279 * MiB;
constexpr size_t WS_END1 = 295 * MiB;
constexpr size_t WS_WGU = 16 * MiB;
constexpr size_t WS_WD = 80 * MiB;
constexpr size_t WS_U2 = 112 * MiB;
constexpr size_t WS_XS = 144 * MiB;
constexpr size_t WS_HS = 224 * MiB;
constexpr size_t WS_NEED = 295 * MiB;
constexpr int CW_TMO = 0, CW_CNT = 1024  , CW_BAR = 4096;
constexpr size_t RT_TOKE = 0, RT_TOKPOS = 128 * 1024, RT_TOKGATE = 256 * 1024, RT_TOKSLOT = 384 * 1024, RT_SGATE = 512 * 1024, RT_WGCNT = 768 * 1024, RT_CNT = 896 * 1024;

constexpr int RING_BYTES = 131072;
constexpr int LB = 8192;
constexpr int L_F32A = 14 * LB, L_F32B = L_F32A + 16384, L_MISC = L_F32B + 16384;
constexpr int L_CTL = L_MISC + 8192;
constexpr int LDS_BYTES = 159744;

#define GAS __attribute__((address_space(1)))
#define LAS __attribute__((address_space(3)))
typedef unsigned short bf16;
typedef unsigned v4u __attribute__((ext_vector_type(4)));
typedef float f32x4 __attribute__((ext_vector_type(4)));
typedef GAS unsigned gu32;
#define RLX_AGENT __ATOMIC_RELAXED, __HIP_MEMORY_SCOPE_AGENT
#define LDS_WAIT() asm volatile("s_waitcnt lgkmcnt(0)" ::: "memory")
#define VM_WAIT() asm volatile("s_waitcnt vmcnt(0)" ::: "memory")
__device__ __forceinline__ unsigned f2bf(float f) { unsigned u = __builtin_bit_cast(unsigned, f); return (u + 0x7fffu + ((u >> 16) & 1u)) >> 16; }
typedef __bf16 bf16x2_t __attribute__((ext_vector_type(2))); typedef float f32x2_t __attribute__((ext_vector_type(2)));
__device__ __forceinline__ unsigned pk2(float lo, float hi) { const f32x2_t v = {lo, hi}; return __builtin_bit_cast(unsigned, __builtin_convertvector(v, bf16x2_t)); }
__device__ __forceinline__ float bf2f(unsigned h) { return __builtin_bit_cast(float, h << 16); }
__device__ __forceinline__ float sigm(float x) { return __builtin_amdgcn_rcpf(1.0f + __expf(-x)); }
__device__ __forceinline__ float wave_sum(float v) {
#pragma unroll
    for (int o = 1; o < 64; o <<= 1) v += __shfl_xor(v, o);
    return v;
}
#define XB_TMO      128
#define XB_XCNT(j)  (256  + 64 * (j))
#define XB_XSUB(j)  (1280 + 64 * (j))
#define XB_XGEN(j)  (2304 + 64 * (j))
#define XB_TOP      3328
#define XB_TOPGEN   3392
#define XCD_BAR_WORDS 3456
#define XB_SPIN_CAP (1u << 18)

__device__ __forceinline__ unsigned xb_ld(unsigned* p)              { return __hip_atomic_load(p, __ATOMIC_RELAXED, __HIP_MEMORY_SCOPE_AGENT); }
__device__ __forceinline__ unsigned xb_add(unsigned* p, unsigned v) { return __hip_atomic_fetch_add(p, v, __ATOMIC_RELAXED, __HIP_MEMORY_SCOPE_AGENT); }
__device__ __forceinline__ unsigned xb_xcc_id() { return (unsigned)__builtin_amdgcn_s_getreg((3 << 11) | 20) & 0xFu; }
#define XB_SPIN(cond, bar) do { unsigned _sp = 0; while (cond) { __builtin_amdgcn_s_sleep(1); \
    if ((++_sp & 255u) == 0u) { if (xb_ld(&(bar)[XB_TMO])) break; if (_sp > XB_SPIN_CAP) { atomicAdd(&(bar)[XB_TMO], 1u); break; } } } } while (0)

struct XcdBarrier {
    unsigned* bar; unsigned x;
    volatile LAS unsigned* st;
};

__device__ __forceinline__ XcdBarrier xcd_barrier_post(unsigned* bar, volatile LAS unsigned* st) {
    XcdBarrier b; b.bar = bar; b.x = xb_xcc_id(); b.st = st;
    if (threadIdx.x == 0) (void)xb_add(&bar[XB_XCNT(b.x)], 1u);
    return b;
}
__device__ __forceinline__ void xcd_barrier_complete(unsigned* bar, unsigned x, unsigned& nloc, unsigned& nx) {
    const unsigned G = gridDim.x * gridDim.y * gridDim.z;
    unsigned sum, cnt, mine, sp = 0u;
    for (;;) {
        sum = 0u; cnt = 0u; mine = 0u;
#pragma unroll
        for (unsigned j = 0; j < 16; ++j) { const unsigned c = xb_ld(&bar[XB_XCNT(j)]); sum += c; cnt += (c > 0u) ? 1u : 0u; mine = (j == x) ? c : mine; }
        if (sum == G) break;
        __builtin_amdgcn_s_sleep(1);
        if ((++sp & 255u) == 0u) { if (xb_ld(&bar[XB_TMO])) break; if (sp > XB_SPIN_CAP) { atomicAdd(&bar[XB_TMO], 1u); break; } }
    }
    nloc = mine > 0u ? mine : 1u; nx = cnt > 0u ? cnt : 1u;
}

__device__ __forceinline__ void xcd_barrier(const XcdBarrier& b) {
    asm volatile("s_waitcnt vmcnt(0)" ::: "memory");
    __syncthreads();
    if (threadIdx.x == 0) {
        unsigned* bar = b.bar;
        __builtin_amdgcn_s_waitcnt(0);
        unsigned nloc = b.st[0], nx = b.st[1];
        if (nloc == 0u) { xcd_barrier_complete(bar, b.x, nloc, nx); b.st[0] = nloc; b.st[1] = nx; }
        const unsigned old = xb_add(&bar[XB_XSUB(b.x)], 1u);
        const unsigned gen = old / nloc;
        if (old + 1u == (gen + 1u) * nloc) {
            __builtin_amdgcn_fence(__ATOMIC_RELEASE, "agent");
            asm volatile("s_waitcnt vmcnt(0)" ::: "memory");
            const unsigned og = xb_add(&bar[XB_TOP], 1u);
            const unsigned tg = og / nx;
            if (og + 1u == (tg + 1u) * nx) xb_add(&bar[XB_TOPGEN], 1u);
            else XB_SPIN(xb_ld(&bar[XB_TOPGEN]) == tg, bar);
            __builtin_amdgcn_fence(__ATOMIC_ACQUIRE, "agent");
            xb_add(&bar[XB_XGEN(b.x)], 1u);
            asm volatile("s_waitcnt vmcnt(0)" ::: "memory");
        } else {
            XB_SPIN(xb_ld(&bar[XB_XGEN(b.x)]) == gen, bar);
            __builtin_amdgcn_fence(__ATOMIC_ACQUIRE, "agent");
            asm volatile("s_waitcnt vmcnt(0)" ::: "memory");
        }
    }
    __syncthreads();
}

struct Args { const float* in[35]; float* out; unsigned char* ws; int ph_lo, ph_hi; };
struct KCtx {
    LAS unsigned char* lds; int tid, lane, wave, vcu, G;
    const Args* a;
};
#define IN_X 0
#define IN_C 1
#define IN_CTX 2
#define IN_CCTX 3
#define IN_EG 4
#define IN_EB 5
#define IN_WMOD 6
#define IN_BMOD 7
#define IN_WIN 8
#define IN_MU 9
#define IN_W0 10
#define IN_W2 11
#define IN_A0 12
#define IN_A2 13
#define IN_G2 14
#define IN_KK 15
#define IN_KA 16
#define IN_RK 17
#define IN_GNG 18
#define IN_GNB 19
#define IN_RDEC 20
#define IN_RGNG 21
#define IN_RGNB 22
#define IN_WOUT 23
#define IN_LN1G 24
#define IN_LN1B 25
#define IN_RG 26
#define IN_RGB 27
#define IN_RE 28
#define IN_REB 29
#define IN_EWG 30
#define IN_EWU 31
#define IN_EWD 32
#define IN_LN2G 33
#define IN_LN2B 34

__device__ __forceinline__ void transpose_item(const float* W, int K, int N, bf16* WT, int row_off, LAS float* scr, int item, int lane) {
    const int nblk = N / 32, kb = item / nblk, nb = item % nblk, k0 = 64 * kb, n0 = 32 * nb;
#pragma unroll 8
    for (int i = 0; i < 32; ++i) { const int kk = 2 * i + (lane >> 5); scr[kk * 33 + (lane & 31)] = W[(size_t)(k0 + kk) * N + n0 + (lane & 31)]; }
    LDS_WAIT(); asm volatile("" ::: "memory");
    const int c = lane & 7;
#pragma unroll
    for (int j = 0; j < 4; ++j) { const int n = (lane >> 3) + 8 * j; const LAS float* s = scr + (8 * c) * 33 + n;
        v4u o; o.x = pk2(s[0 * 33], s[1 * 33]); o.y = pk2(s[2 * 33], s[3 * 33]); o.z = pk2(s[4 * 33], s[5 * 33]); o.w = pk2(s[6 * 33], s[7 * 33]);
        *(GAS v4u*)(WT + (size_t)(row_off + n0 + n) * K + k0 + 8 * c) = o; }
    LDS_WAIT(); asm volatile("" ::: "memory");
}

__device__ __forceinline__ void phase0(const KCtx& X) {
    float* mod = (float*)(X.a->ws + WS_MOD);
    LAS float* sc = (LAS float*)X.lds;
    LAS float* red = sc + 3072;
    const float* wmod = X.a->in[IN_WMOD];
    for (int tile = X.vcu; tile < 192; tile += X.G) {
        for (int i = X.tid; i < 3072; i += NTHR) { const int b = i >> 10, k = i & 1023; const float c = b < 2 ? X.a->in[IN_C][b * 1024 + k] : X.a->in[IN_CCTX][k]; sc[i] = c * sigm(c); }
        __syncthreads();
        const int cq = X.tid & 7, kg = X.tid >> 3; float acc[3][4];
#pragma unroll
        for (int b = 0; b < 3; ++b)
#pragma unroll
            for (int j = 0; j < 4; ++j) acc[b][j] = 0.f;
#pragma unroll 4
        for (int kk = 0; kk < 16; ++kk) { const int k = kg * 16 + kk; const f32x4 w = *(const f32x4*)(wmod + (size_t)k * 6144 + tile * 32 + cq * 4);
#pragma unroll
            for (int b = 0; b < 3; ++b) { const float s = sc[b * 1024 + k];
#pragma unroll
                for (int j = 0; j < 4; ++j) acc[b][j] += s * w[j]; } }
#pragma unroll
        for (int b = 0; b < 3; ++b)
#pragma unroll
            for (int j = 0; j < 4; ++j) red[kg * 96 + cq * 12 + b * 4 + j] = acc[b][j];
        __syncthreads();
        if (X.tid < 96) { float s = 0.f; for (int g = 0; g < 64; ++g) s += red[g * 96 + X.tid];
            const int q = X.tid / 12, b = (X.tid % 12) / 4, j = X.tid & 3, col = tile * 32 + q * 4 + j; mod[b * 6144 + col] = s + X.a->in[IN_BMOD][col]; }
        __syncthreads();
    }
    LAS float* scr = (LAS float*)(X.lds + 40960 + X.wave * 8704);
    const int gw = X.vcu * NWAVES + X.wave, NGW = X.G * NWAVES;
    bf16* WinT = (bf16*)(X.a->ws + WS_WIN); bf16* WoutT = (bf16*)(X.a->ws + WS_WOUT); bf16* W2T = (bf16*)(X.a->ws + WS_W2T); bf16* A2T = (bf16*)(X.a->ws + WS_A2T); bf16* G2T = (bf16*)(X.a->ws + WS_G2T);
    constexpr int I_IN = 16 * 124, I_OUT = 16 * 32, I_L = 16, I_G = 32;
    constexpr int NIT = I_IN + I_OUT + 4 * I_L + I_G;
    for (int it = gw; it < NIT; it += NGW) {
        int r = it;
        if (r < I_IN) { transpose_item(X.a->in[IN_WIN], 1024, NIN, WinT, 0, scr, r, X.lane); continue; } r -= I_IN;
        if (r < I_OUT) { transpose_item(X.a->in[IN_WOUT], 1024, 1024, WoutT, 0, scr, r, X.lane); continue; } r -= I_OUT;
        if (r < I_L) { transpose_item(X.a->in[IN_W2], 64, 512, W2T, 0, scr, r, X.lane); continue; } r -= I_L;
        if (r < I_L) { transpose_item(X.a->in[IN_W2] + 64 * 512, 64, 512, W2T + 512 * 64, 0, scr, r, X.lane); continue; } r -= I_L;
        if (r < I_L) { transpose_item(X.a->in[IN_A2], 64, 512, A2T, 0, scr, r, X.lane); continue; } r -= I_L;
        if (r < I_L) { transpose_item(X.a->in[IN_A2] + 64 * 512, 64, 512, A2T + 512 * 64, 0, scr, r, X.lane); continue; } r -= I_L;
        transpose_item(X.a->in[IN_G2], 128, 512, G2T, 0, scr, r, X.lane);
    }
    const int gt = X.vcu * NTHR + X.tid, NGT = X.G * NTHR;
    for (int i = gt; i < 128 * 1024 / 8; i += NGT) *(GAS v4u*)(WinT + (size_t)NIN * 1024 + (size_t)i * 8) = (v4u){0u, 0u, 0u, 0u};
    float* RTt = (float*)(X.a->ws + WS_RT);
    for (int i = gt; i < 36 * 1024; i += NGT) { const int e = i >> 10, k = i & 1023; RTt[i] = e < 4 ? X.a->in[IN_RG][k * 4 + e] : X.a->in[IN_RE][k * 32 + (e - 4)]; }
    float* rope = (float*)(X.a->ws + WS_ROPE);
    for (int i = gt; i < 128 * 32; i += NGT) { const int pos = i >> 5, f = i & 31; const float inv = exp2f(-(float)f * (13.287712379549449f / 32.0f)); const float ang = (float)pos * inv;
        float rv = ang * 0.15915494309189535f; rv -= rintf(rv); rope[2 * i] = __builtin_amdgcn_cosf(rv); rope[2 * i + 1] = __builtin_amdgcn_sinf(rv); }
}

__device__ __forceinline__ void phase1(const KCtx& X) {
    const float* mod = (const float*)(X.a->ws + WS_MOD); float* stats = (float*)(X.a->ws + WS_STATS); bf16* U = (bf16*)(X.a->ws + WS_U);
    const int gw = X.vcu * NWAVES + X.wave, NGW = X.G * NWAVES;
    for (int m = gw; m < MALL; m += NGW) {
        const float* src = m < MLAT ? X.a->in[IN_X] + (size_t)m * D : X.a->in[IN_CTX] + (size_t)(m - MLAT) * D;
        const float* mr = mod + (m < MLAT ? (m >> 13) : 2) * 6144;
        f32x4 v[4]; float s = 0.f;
#pragma unroll
        for (int j = 0; j < 4; ++j) { v[j] = *(const f32x4*)(src + 4 * X.lane + 256 * j); s += (v[j].x + v[j].y) + (v[j].z + v[j].w); }
        const float mean = wave_sum(s) * (1.f / D); float s2 = 0.f;
#pragma unroll
        for (int j = 0; j < 4; ++j) { v[j] = v[j] - mean; s2 += (v[j].x * v[j].x + v[j].y * v[j].y) + (v[j].z * v[j].z + v[j].w * v[j].w); }
        const float rstd = 1.f / sqrtf(wave_sum(s2) * (1.f / D) + LN_EPS);
        if (X.lane == 0) { stats[2 * m] = mean; stats[2 * m + 1] = rstd; }
#pragma unroll
        for (int j = 0; j < 4; ++j) { const int c = 4 * X.lane + 256 * j;
            const f32x4 g = *(const f32x4*)(X.a->in[IN_EG] + c), bb = *(const f32x4*)(X.a->in[IN_EB] + c), sh = *(const f32x4*)(mr + c), sc = *(const f32x4*)(mr + 1024 + c);
            const f32x4 h = v[j] * rstd * g + bb; const f32x4 u = h * (sc + 1.0f) + sh;
            unsigned long long o = (unsigned long long)pk2(u.x, u.y) | ((unsigned long long)pk2(u.z, u.w) << 32);
            *(unsigned long long*)(U + (size_t)m * D + c) = o; }
    }
}
#ifdef PROBE_A
#define TACC(i) do { if (blockIdx.x == 0 && X.tid == 0) { volatile LAS unsigned long long* A_ = (volatile LAS unsigned long long*)(X.lds + L_CTL + 384); const unsigned long long n_ = __builtin_amdgcn_s_memrealtime(); A_[i] += n_ - A_[15]; A_[15] = n_; } } while (0)
#define TACC_RESET() do { if (blockIdx.x == 0 && X.tid == 0) { volatile LAS unsigned long long* A_ = (volatile LAS unsigned long long*)(X.lds + L_CTL + 384); A_[15] = __builtin_amdgcn_s_memrealtime(); } } while (0)
#else
#define TACC(i) do {} while (0)
#define TACC_RESET() do {} while (0)
#endif
__device__ __forceinline__ int sw(int r, int c) { return r * 64 + ((((c >> 3) ^ r) & 7) << 3) + (c & 7); }
#define BUF(i) ((LAS bf16*)(X.lds + (i) * LB))
#define MM64(XE, YE, KD, OUT) do { _Pragma("unroll 1") for (int q_ = 0; q_ < 8; ++q_) { const int a = q_ * 8 + X.wave, b = X.lane; float acc = 0.f; \
    _Pragma("unroll 8") for (int k = 0; k < (KD); ++k) acc += (XE) * (YE); OUT; } } while (0)
#define MM64_2(XE1, YE1, XE2, YE2, KD, OUT) do { _Pragma("unroll 1") for (int q_ = 0; q_ < 8; ++q_) { const int a = q_ * 8 + X.wave, b = X.lane; float acc = 0.f; \
    _Pragma("unroll 8") for (int k = 0; k < (KD); ++k) acc += (XE1) * (YE1) - (XE2) * (YE2); OUT; } } while (0)

__device__ __forceinline__ void load_shift8(const bf16* Pb, const float* mu, int b, bool isctx, int t, int c0, float (&o)[8]) {
    const size_t row = isctx ? (size_t)(MLAT + b * CTX + t) : (size_t)(b * T + t);
    const bf16* p = Pb + row * PP + c0;
    const v4u self = *(const v4u*)p;
    v4u n0 = (v4u){0u, 0u, 0u, 0u}, n1 = n0, n2 = n0, n3 = n0;
    if (isctx) { if (t > 0) n0 = *(const v4u*)(p - PP); if (t < CTX - 1) n1 = *(const v4u*)(p + PP); n2 = n0; n3 = n1; }
    else { const int col = t & 63;
        if (col > 0) n0 = *(const v4u*)(p - PP); if (col < 63) n1 = *(const v4u*)(p + PP);
        if (t >= 64) n2 = *(const v4u*)(p - 64 * PP); if (t < T - 64) n3 = *(const v4u*)(p + 64 * PP); }
    const f32x4 m0 = *(const f32x4*)(mu + c0), m1 = *(const f32x4*)(mu + c0 + 4);
    const unsigned sw_[4] = {self.x, self.y, self.z, self.w};
    const unsigned a0[4] = {n0.x, n0.y, n0.z, n0.w}, a1[4] = {n1.x, n1.y, n1.z, n1.w}, a2[4] = {n2.x, n2.y, n2.z, n2.w}, a3[4] = {n3.x, n3.y, n3.z, n3.w};
#pragma unroll
    for (int w = 0; w < 4; ++w) {
        const int j0 = 2 * w, j1 = 2 * w + 1;
        const float p0 = bf2f(sw_[w] & 0xffffu), p1 = bf2f(sw_[w] >> 16);
        const unsigned s0 = ((j0 & 3) == 0) ? a0[w] : a2[w];
        const unsigned s1 = ((j1 & 3) == 1) ? a1[w] : a3[w];
        const float q0 = bf2f(s0 & 0xffffu), q1 = bf2f(s1 >> 16);
        const float mu0 = j0 < 4 ? m0[j0] : m1[j0 - 4], mu1 = j1 < 4 ? m0[j1] : m1[j1 - 4];
        o[j0] = p0 + mu0 * (q0 - p0); o[j1] = p1 + mu1 * (q1 - p1);
    }
}
__device__ __forceinline__ void store8(LAS bf16* buf, int r, int chunk, const float (&v)[8]) {
    v4u o; o.x = pk2(v[0], v[1]); o.y = pk2(v[2], v[3]); o.z = pk2(v[4], v[5]); o.w = pk2(v[6], v[7]);
    *(LAS v4u*)(buf + r * 64 + (((chunk ^ r) & 7) << 3)) = o;
}

typedef short bf16x8 __attribute__((ext_vector_type(8)));
typedef short s16x4 __attribute__((ext_vector_type(4)));
typedef unsigned u32x2 __attribute__((ext_vector_type(2)));
__device__ __forceinline__ bf16x8 fr_row(const LAS bf16* buf, int r0, int ks, int lane) {
    const int row = r0 + (lane & 15), ch = 4 * ks + (lane >> 4);
    return *(const LAS bf16x8*)(buf + row * 64 + (((ch ^ row) & 7) << 3));
}
__device__ __forceinline__ bf16x8 fr_tr(const LAS bf16* buf, int c0, int ks, int lane) {
    const int g = lane >> 4, q = (lane >> 2) & 3, p = lane & 3, col = c0 + 4 * p;
    const int k0 = 32 * ks + 8 * g + q, k1 = k0 + 4;
    const s16x4 lo = __builtin_amdgcn_ds_read_tr16_b64_v4i16((LAS s16x4*)(buf + k0 * 64 + ((((col >> 3) ^ k0) & 7) << 3) + (col & 7)));
    const s16x4 hi = __builtin_amdgcn_ds_read_tr16_b64_v4i16((LAS s16x4*)(buf + k1 * 64 + ((((col >> 3) ^ k1) & 7) << 3) + (col & 7)));
    return (bf16x8){lo[0], lo[1], lo[2], lo[3], hi[0], hi[1], hi[2], hi[3]};
}
__device__ __forceinline__ void st4(LAS bf16* buf, int r, int c0, float v0, float v1, float v2, float v3) {
    u32x2 o; o.x = pk2(v0, v1); o.y = pk2(v2, v3); *(LAS u32x2*)(buf + sw(r, c0)) = o;
}
__device__ __forceinline__ f32x4 ld4(const LAS bf16* buf, int r, int c0) {
    const u32x2 o = *(const LAS u32x2*)(buf + sw(r, c0)); return (f32x4){bf2f(o.x & 0xffffu), bf2f(o.x >> 16), bf2f(o.y & 0xffffu), bf2f(o.y >> 16)};
}
__device__ __forceinline__ f32x4 mk4(float a, float b, float c, float d) { return (f32x4){a, b, c, d}; }
__device__ __forceinline__ void stg4(bf16* p, float v0, float v1, float v2, float v3) { u32x2 o; o.x = pk2(v0, v1); o.y = pk2(v2, v3); *(u32x2*)p = o; }
#define MMA_NAT(KX, BX, KY, BY, EPI) do { int ln_ = X.lane; asm volatile("" : "+v"(ln_)); const int ta_ = X.wave & 3, a_ = 16 * ta_ + (ln_ & 15); \
    const bf16x8 x0_ = KX(BX, 16 * ta_, 0, ln_), x1_ = KX(BX, 16 * ta_, 1, ln_); \
    _Pragma("unroll") for (int tt_ = 0; tt_ < 2; ++tt_) { const int tb_ = 2 * (X.wave >> 2) + tt_; const int b0_ = 16 * tb_ + 4 * (ln_ >> 4); \
        const bf16x8 y0_ = KY(BY, 16 * tb_, 0, ln_), y1_ = KY(BY, 16 * tb_, 1, ln_); f32x4 acc = {0.f, 0.f, 0.f, 0.f}; \
        acc = __builtin_amdgcn_mfma_f32_16x16x32_bf16(y0_, x0_, acc, 0, 0, 0); acc = __builtin_amdgcn_mfma_f32_16x16x32_bf16(y1_, x1_, acc, 0, 0, 0); \
        { EPI; } } } while (0)
#define MMA_NAT2(KX1, BX1, KY1, BY1, KX2, BX2, KY2, BY2, EPI) do { int ln_ = X.lane; asm volatile("" : "+v"(ln_)); const int ta_ = X.wave & 3, a_ = 16 * ta_ + (ln_ & 15); \
    const bf16x8 x0_ = KX1(BX1, 16 * ta_, 0, ln_), x1_ = KX1(BX1, 16 * ta_, 1, ln_), x2_ = KX2(BX2, 16 * ta_, 0, ln_), x3_ = KX2(BX2, 16 * ta_, 1, ln_); \
    _Pragma("unroll") for (int tt_ = 0; tt_ < 2; ++tt_) { const int tb_ = 2 * (X.wave >> 2) + tt_; const int b0_ = 16 * tb_ + 4 * (ln_ >> 4); \
        const bf16x8 y0_ = KY1(BY1, 16 * tb_, 0, ln_), y1_ = KY1(BY1, 16 * tb_, 1, ln_), y2_ = KY2(BY2, 16 * tb_, 0, ln_), y3_ = KY2(BY2, 16 * tb_, 1, ln_); \
        f32x4 acc = {0.f, 0.f, 0.f, 0.f}, acn = {0.f, 0.f, 0.f, 0.f}; \
        acc = __builtin_amdgcn_mfma_f32_16x16x32_bf16(y0_, x0_, acc, 0, 0, 0); acc = __builtin_amdgcn_mfma_f32_16x16x32_bf16(y1_, x1_, acc, 0, 0, 0); \
        acn = __builtin_amdgcn_mfma_f32_16x16x32_bf16(y2_, x2_, acn, 0, 0, 0); acn = __builtin_amdgcn_mfma_f32_16x16x32_bf16(y3_, x3_, acn, 0, 0, 0); acc = acc - acn; \
        { EPI; } } } while (0)

struct FragOff { int row[2]; int trx[2][2]; int try0[2][2]; int so0; int a_, bq; };
__device__ __forceinline__ void fragoff_init(FragOff& F, int lane, int wave) {
    const int g = lane >> 4, q = (lane >> 2) & 3, p = lane & 3, ta = wave & 3, tbb = 2 * (wave >> 2);
#pragma unroll
    for (int ks = 0; ks < 2; ++ks) { F.row[ks] = (lane & 15) * 64 + ((((4 * ks + g) ^ lane) & 7) << 3);
#pragma unroll
        for (int hf = 0; hf < 2; ++hf) { const int k = 32 * ks + 8 * g + q + 4 * hf, L = (p >> 1) ^ (k & 7);
            F.trx[ks][hf] = k * 64 + (((2 * ta) ^ L) << 3) + 4 * (p & 1);
            F.try0[ks][hf] = k * 64 + (((2 * tbb) ^ L) << 3) + 4 * (p & 1); } }
    F.a_ = 16 * ta + (lane & 15); F.bq = 4 * g;
    const int Ls = (g >> 1) ^ (lane & 7);
    F.so0 = F.a_ * 64 + (((2 * tbb) ^ Ls) << 3) + 4 * (g & 1);
}
struct Frag2 { bf16x8 k0, k1; };
__device__ __forceinline__ Frag2 frow(const FragOff& F, const LAS bf16* buf, int tile) { Frag2 f; f.k0 = *(const LAS bf16x8*)(buf + tile * 1024 + F.row[0]); f.k1 = *(const LAS bf16x8*)(buf + tile * 1024 + F.row[1]); return f; }
__device__ __forceinline__ Frag2 ftr4(const LAS bf16* buf, int o00, int o01, int o10, int o11) {
    const s16x4 a = __builtin_amdgcn_ds_read_tr16_b64_v4i16((LAS s16x4*)(buf + o00)), b = __builtin_amdgcn_ds_read_tr16_b64_v4i16((LAS s16x4*)(buf + o01));
    const s16x4 c = __builtin_amdgcn_ds_read_tr16_b64_v4i16((LAS s16x4*)(buf + o10)), d = __builtin_amdgcn_ds_read_tr16_b64_v4i16((LAS s16x4*)(buf + o11));
    Frag2 f; f.k0 = (bf16x8){a[0], a[1], a[2], a[3], b[0], b[1], b[2], b[3]}; f.k1 = (bf16x8){c[0], c[1], c[2], c[3], d[0], d[1], d[2], d[3]}; return f;
}
#define FTRX(buf) ftr4(buf, F.trx[0][0], F.trx[0][1], F.trx[1][0], F.trx[1][1])
#define FTRY(buf, tt) ftr4(buf, F.try0[0][0] ^ (16 * (tt)), F.try0[0][1] ^ (16 * (tt)), F.try0[1][0] ^ (16 * (tt)), F.try0[1][1] ^ (16 * (tt)))
__device__ __forceinline__ f32x4 mm2(const Frag2& y, const Frag2& x, f32x4 acc) { acc = __builtin_amdgcn_mfma_f32_16x16x32_bf16(y.k0, x.k0, acc, 0, 0, 0); return __builtin_amdgcn_mfma_f32_16x16x32_bf16(y.k1, x.k1, acc, 0, 0, 0); }
__device__ __forceinline__ void st4o(LAS bf16* buf, int off, f32x4 v) { u32x2 o; o.x = pk2(v[0], v[1]); o.y = pk2(v[2], v[3]); *(LAS u32x2*)(buf + off) = o; }
__device__ __forceinline__ f32x4 ld4o(const LAS bf16* buf, int off) { const u32x2 o = *(const LAS u32x2*)(buf + off); return (f32x4){bf2f(o.x & 0xffffu), bf2f(o.x >> 16), bf2f(o.y & 0xffffu), bf2f(o.y >> 16)}; }
#define ZERO4 ((f32x4){0.f, 0.f, 0.f, 0.f})

#ifndef PF_NEXT_RKV
#define PF_NEXT_RKV 1
#endif
struct Raw5 { v4u s; unsigned n0a, n0b, n1a, n1b, n2a, n2b, n3a, n3b; };
__device__ __forceinline__ void raw_issue(Raw5& R, const bf16* Pb, int b, bool isctx, int t, int c0) {
    const size_t row = isctx ? (size_t)(MLAT + b * CTX + t) : (size_t)(b * T + t);
    const unsigned* p = (const unsigned*)(Pb + row * PP + c0);
    constexpr int PW = PP / 2;
    R.s = *(const v4u*)p; R.n0a = R.n0b = R.n1a = R.n1b = R.n2a = R.n2b = R.n3a = R.n3b = 0u;
    if (isctx) { if (t > 0) { R.n0a = p[-PW]; R.n0b = p[-PW + 2]; R.n2a = p[-PW + 1]; R.n2b = p[-PW + 3]; } if (t < CTX - 1) { R.n1a = p[PW]; R.n1b = p[PW + 2]; R.n3a = p[PW + 1]; R.n3b = p[PW + 3]; } }
    else { const int col = t & 63;
        if (col > 0) { R.n0a = p[-PW]; R.n0b = p[-PW + 2]; } if (col < 63) { R.n1a = p[PW]; R.n1b = p[PW + 2]; }
        if (t >= 64) { R.n2a = p[-64 * PW + 1]; R.n2b = p[-64 * PW + 3]; } if (t < T - 64) { R.n3a = p[64 * PW + 1]; R.n3b = p[64 * PW + 3]; } }
}
__device__ __forceinline__ void raw_finish(const Raw5& R, bool isctx, const LAS float* mul, float (&o)[8]) {
    const f32x4 m0 = *(const LAS f32x4*)mul, m1 = *(const LAS f32x4*)(mul + 4);
    const unsigned sw_[4] = {R.s.x, R.s.y, R.s.z, R.s.w};
    const unsigned lo_[4] = {R.n0a, R.n2a, R.n0b, R.n2b}, hi_[4] = {R.n1a, R.n3a, R.n1b, R.n3b};
    (void)isctx;
#pragma unroll
    for (int w = 0; w < 4; ++w) { const int j0 = 2 * w, j1 = 2 * w + 1;
        const float p0 = bf2f(sw_[w] & 0xffffu), p1 = bf2f(sw_[w] >> 16);
        const float q0 = bf2f(lo_[w] & 0xffffu), q1 = bf2f(hi_[w] >> 16);
        const float mu0 = j0 < 4 ? m0[j0] : m1[j0 - 4], mu1 = j1 < 4 ? m0[j1] : m1[j1 - 4];
        o[j0] = p0 + mu0 * (q0 - p0); o[j1] = p1 + mu1 * (q1 - p1); }
}
__device__ __forceinline__ v4u pack8(const float (&v)[8]) { v4u o; o.x = pk2(v[0], v[1]); o.y = pk2(v[2], v[3]); o.z = pk2(v[4], v[5]); o.w = pk2(v[6], v[7]); return o; }
__device__ __forceinline__ void unpack8(const v4u p, float (&v)[8]) { v[0] = bf2f(p.x & 0xffffu); v[1] = bf2f(p.x >> 16); v[2] = bf2f(p.y & 0xffffu); v[3] = bf2f(p.y >> 16); v[4] = bf2f(p.z & 0xffffu); v[5] = bf2f(p.z >> 16); v[6] = bf2f(p.w & 0xffffu); v[7] = bf2f(p.w >> 16); }
__device__ __forceinline__ void stv(LAS bf16* buf, int r, int chunk, const v4u v) { *(LAS v4u*)(buf + r * 64 + (((chunk ^ r) & 7) << 3)) = v; }
#define DPP_ADD(v, ctrl, rowmask) v = v + __builtin_bit_cast(float, __builtin_amdgcn_update_dpp(0, __builtin_bit_cast(int, v), ctrl, rowmask, 0xf, false))
#define DPP_SUM(v) do { DPP_ADD(v, 0xB1, 0xf); DPP_ADD(v, 0x4E, 0xf); DPP_ADD(v, 0x141, 0xf); DPP_ADD(v, 0x140, 0xf); DPP_ADD(v, 0x142, 0xa); DPP_ADD(v, 0x143, 0xc); } while (0)

struct UnitGeo { int b, h, blk, t0; bool isctx; };
__device__ __forceinline__ UnitGeo unit_geo(int unit) { UnitGeo g; g.blk = unit % NCHUNK; const int bh = unit / NCHUNK; g.b = bh >> 3; g.h = bh & 7; g.isctx = g.blk < 4; g.t0 = g.isctx ? g.blk * 64 : (g.blk - 4) * 64; return g; }
struct DirIn { v4u lw, la, w2, a2; };

#define RW_BUFS LAS bf16 *SR = BUF(0), *SK = BUF(1), *SV = BUF(2), *SKK = BUF(3), *TL = BUF(4), *LA = BUF(5), *W2h = BUF(6), *A2h = BUF(7); \
    LAS bf16 *AKA = BUF(4), *BKR = BUF(5), *BBR = BUF(6), *AM = BUF(7), *RT = BUF(8), *AT = BUF(9), *KB = BUF(10), *BB = BUF(11), *VA = BUF(13), *PPm = BUF(16), *QQ = BUF(4); \
    LAS bf16 *MA = BUF(12), *MB = BUF(15), *PA = BUF(14), *PB = BUF(16); \
    LAS float* F32A = (LAS float*)(X.lds + L_F32A); LAS float* F32B = (LAS float*)(X.lds + L_F32B); \
    LAS float* eL = (LAS float*)(X.lds + L_MISC); LAS float* TOT = eL + 64; LAS float* BON = TOT + 512; LAS float* PRM = BON + 64; LAS float* MUL = PRM + 384; \
    (void)SR; (void)SK; (void)SV; (void)SKK; (void)TL; (void)LA; (void)W2h; (void)A2h; (void)AKA; (void)BKR; (void)BBR; (void)AM; (void)RT; (void)AT; (void)KB; (void)BB; (void)VA; (void)PPm; (void)QQ; \
    (void)MA; (void)MB; (void)PA; (void)PB; (void)F32A; (void)F32B; (void)eL; (void)TOT; (void)BON; (void)PRM; (void)MUL

__device__ __forceinline__ void dir_s1_store(const KCtx& X0, const DirIn& in) {
    KCtx X = X0; { int t_ = X0.tid; asm volatile("" : "+v"(t_)); X.tid = t_; X.lane = t_ & 63; }
    RW_BUFS; const int tok = X.tid >> 3, sub = X.tid & 7;
    stv(TL, tok, sub, in.lw); stv(LA, tok, sub, in.la); stv(W2h, tok, sub, in.w2); stv(A2h, tok, sub, in.a2);
}
template <int DIR> __device__ __forceinline__ void dir_s2(const KCtx& X0, const FragOff& F) {
    KCtx X = X0; { int t_ = X0.tid; asm volatile("" : "+v"(t_)); X.tid = t_; X.lane = t_ & 63; }
    RW_BUFS; const int ta = X.wave & 3, tbb = 2 * (X.wave >> 2), a_ = F.a_;
    const Frag2 xT = frow(F, TL, ta), xL = frow(F, LA, ta);
#pragma unroll
    for (int tt = 0; tt < 2; ++tt) { const int tb = tbb + tt, b0_ = 16 * tb + F.bq;
        const f32x4 aw = mm2(frow(F, W2h, tb), xT, ZERO4), aa = mm2(frow(F, A2h, tb), xL, ZERO4);
        const f32x4 w0 = *(const LAS f32x4*)(PRM + DIR * 64 + b0_), a0 = *(const LAS f32x4*)(PRM + 128 + DIR * 64 + b0_); f32x4 o1, o2;
#pragma unroll
        for (int i = 0; i < 4; ++i) { o1[i] = -0.6065306597126334f * sigm(w0[i] + aw[i]); o2[i] = sigm(a0[i] + aa[i]); }
        *(LAS f32x4*)(F32A + a_ * 64 + b0_) = o1; *(LAS f32x4*)(F32B + a_ * 64 + b0_) = o2; }
}
template <int DIR> __device__ __forceinline__ void dir_s3(const KCtx& X0) {
    KCtx X = X0; { int t_ = X0.tid; asm volatile("" : "+v"(t_)); X.tid = t_; X.lane = t_ & 63; }
    RW_BUFS; const int n = X.lane, g = X.wave; float lw8[8], cp[8], cx[8]; float run = 0.f, prod = 1.f;
#pragma unroll
    for (int i = 0; i < 8; ++i) lw8[i] = F32A[(8 * g + i) * 64 + n];
#pragma unroll
    for (int ii = 0; ii < 8; ++ii) { const int i = DIR ? 7 - ii : ii; run += lw8[i]; cx[i] = prod; prod *= __expf(lw8[i]); cp[i] = prod; }
    TOT[g * 64 + n] = run;
    __syncthreads();
    float off = 0.f, tot = 0.f;
#pragma unroll
    for (int g2 = 0; g2 < 8; ++g2) { const float tv = TOT[g2 * 64 + n]; tot += tv; if (DIR ? (g2 > g) : (g2 < g)) off += tv; }
    if (g == 0) eL[n] = __expf(tot);
    const float eo = __expf(off), ka = PRM[256 + n], rk = PRM[320 + n];
    float bs[8];
#pragma unroll
    for (int i = 0; i < 8; ++i) { const int t = 8 * g + i; const float ei = eo * cp[i], ee = eo * cx[i], en = __builtin_amdgcn_rcpf(ei);
        const float av = F32B[t * 64 + n], r = bf2f(SR[sw(t, n)]), k = bf2f(SK[sw(t, n)]), kk = bf2f(SKK[sw(t, n)]);
        const float kd = k * (1.0f + (av - 1.0f) * ka);
        const unsigned p1 = pk2(r * ei, kk * ee), p2 = pk2(kd * en, kk * av * en);
        RT[sw(t, n)] = (bf16)(p1 & 0xffffu); AT[sw(t, n)] = (bf16)(p1 >> 16); KB[sw(t, n)] = (bf16)(p2 & 0xffffu); BB[sw(t, n)] = (bf16)(p2 >> 16);
        bs[i] = r * kd * rk; }
#pragma unroll
    for (int i = 0; i < 8; ++i) DPP_SUM(bs[i]);
    if (n == 63) {
#pragma unroll
        for (int i = 0; i < 8; ++i) { if (DIR == 0) BON[8 * g + i] = bs[i]; else BON[8 * g + i] += bs[i]; } }
}
template <int DIR> __device__ __forceinline__ void dir_s4(const KCtx& X0, const FragOff& F) {
    KCtx X = X0; { int t_ = X0.tid; asm volatile("" : "+v"(t_)); X.tid = t_; X.lane = t_ & 63; }
    RW_BUFS; const int ta = X.wave & 3, tbb = 2 * (X.wave >> 2), a_ = F.a_;
    const Frag2 xK = frow(F, KB, ta), xB = frow(F, BB, ta);
#pragma unroll 1
    for (int tt = 0; tt < 2; ++tt) { const int tb = tbb + tt, b0_ = 16 * tb + F.bq; const Frag2 yA = frow(F, AT, tb), yR = frow(F, RT, tb);
        f32x4 ka = mm2(yA, xK, ZERO4), ba = mm2(yA, xB, ZERO4), kr = mm2(yR, xK, ZERO4), br = mm2(yR, xB, ZERO4), m0;
#pragma unroll
        for (int i = 0; i < 4; ++i) { const int t = b0_ + i; const bool st = DIR ? a_ > t : a_ < t, inc_ = DIR ? a_ >= t : a_ <= t;
            ka[i] = st ? ka[i] : 0.f; ba[i] = st ? ba[i] : 0.f; kr[i] = inc_ ? kr[i] : 0.f; br[i] = inc_ ? br[i] : 0.f; m0[i] = (a_ == t ? 1.f : 0.f) - ba[i]; }
        st4o(AKA, (F.so0 ^ (16 * tt)), ka); st4o(AM, (F.so0 ^ (16 * tt)), ba); st4o(MA, (F.so0 ^ (16 * tt)), m0); st4o(BKR, (F.so0 ^ (16 * tt)), kr); st4o(BBR, (F.so0 ^ (16 * tt)), br); }
}
__device__ __forceinline__ void dir_s5(const KCtx& X0, const FragOff& F) {
    KCtx X = X0; { int t_ = X0.tid; asm volatile("" : "+v"(t_)); X.tid = t_; X.lane = t_ & 63; }
    RW_BUFS; const int ta = X.wave & 3;
    const Frag2 xV = FTRX(SV), xA = frow(F, AM, ta);
#pragma unroll 1
    for (int tt = 0; tt < 2; ++tt) { st4o(VA, (F.so0 ^ (16 * tt)), mm2(FTRY(AKA, tt), xV, ZERO4)); st4o(PA, (F.so0 ^ (16 * tt)), mm2(FTRY(AM, tt), xA, ZERO4)); }
}
__device__ __forceinline__ void dir_neu(const KCtx& X0, const FragOff& F, const LAS bf16* MS, const LAS bf16* PS, LAS bf16* MD, LAS bf16* PD, bool dop) {
    KCtx X = X0; { int t_ = X0.tid; asm volatile("" : "+v"(t_)); X.tid = t_; X.lane = t_ & 63; }
    const int ta = X.wave & 3; const Frag2 xM = frow(F, MS, ta), xP = frow(F, PS, ta);
#pragma unroll 1
    for (int tt = 0; tt < 2; ++tt) { const Frag2 yP = FTRY(PS, tt);
        st4o(MD, (F.so0 ^ (16 * tt)), mm2(yP, xM, ld4o(MS, (F.so0 ^ (16 * tt))))); if (dop) st4o(PD, (F.so0 ^ (16 * tt)), mm2(yP, xP, ZERO4)); }
}
__device__ __forceinline__ void dir_s6(const KCtx& X0, const FragOff& F) {
    KCtx X = X0; { int t_ = X0.tid; asm volatile("" : "+v"(t_)); X.tid = t_; X.lane = t_ & 63; }
    RW_BUFS; const int ta = X.wave & 3;
    const Frag2 xA = FTRX(AT), xV = frow(F, VA, ta);
#pragma unroll 1
    for (int tt = 0; tt < 2; ++tt) { const Frag2 yM = FTRY(MB, tt); st4o(PPm, (F.so0 ^ (16 * tt)), mm2(yM, xA, ZERO4)); st4o(QQ, (F.so0 ^ (16 * tt)), mm2(yM, xV, ZERO4)); }
}
template <int DIR> __device__ __forceinline__ void dir_s7(const KCtx& X0, const FragOff& F, const UnitGeo& U, f32x4& hc0, f32x4& hc1) {
    KCtx X = X0; { int t_ = X0.tid; asm volatile("" : "+v"(t_)); X.tid = t_; X.lane = t_ & 63; }
    RW_BUFS; const int ta = X.wave & 3, tbb = 2 * (X.wave >> 2), a_ = F.a_, hb = U.h * 64;
    const int chain = (U.b * 8 + U.h) * 2 + DIR;
    const int s = DIR ? (U.blk < 4 ? 3 - U.blk : 4 + 127 - (U.blk - 4)) : U.blk;
    bf16* PhiT = (bf16*)(X.a->ws + WS_PHIPSI) + ((size_t)chain * NCHUNK + s) * 8192; bf16* Psi = PhiT + 4096;
    const Frag2 xBB = FTRX(BB), xBBR = FTRX(BBR), xSV = FTRX(SV), xQQ = frow(F, QQ, ta), xBKR = FTRX(BKR);
    const float ea = eL[a_];
    bf16* GT = (bf16*)X.a->out + ((size_t)chain * 128 + (U.blk - 4)) * 4096;
    bf16* Hb = (bf16*)(X.a->ws + WS_HB) + ((size_t)(U.b * T + U.t0)) * 512 + hb;
#pragma unroll 1
    for (int tt = 0; tt < 2; ++tt) { const int tb = tbb + tt, b0_ = 16 * tb + F.bq;
        const Frag2 yP = frow(F, PPm, tb), yKB = FTRY(KB, tt), yBB = FTRY(BB, tt);
        { const f32x4 acc = mm2(yP, xBB, ZERO4); stg4(PhiT + a_ * 64 + b0_, (a_ == b0_ ? ea : 0.f) - ea * acc[0], (a_ == b0_ + 1 ? ea : 0.f) - ea * acc[1], (a_ == b0_ + 2 ? ea : 0.f) - ea * acc[2], (a_ == b0_ + 3 ? ea : 0.f) - ea * acc[3]); }
        { const f32x4 acc = mm2(yKB, xSV, ZERO4) - mm2(yBB, xQQ, ZERO4); const f32x4 e = *(const LAS f32x4*)(eL + b0_); stg4(Psi + a_ * 64 + b0_, e[0] * acc[0], e[1] * acc[1], e[2] * acc[2], e[3] * acc[3]); }
        if (!U.isctx) {
            { const f32x4 acc = mm2(yP, xBBR, ZERO4); const f32x4 r_ = ld4o(RT, (F.so0 ^ (16 * tt))); stg4(GT + a_ * 64 + b0_, r_[0] - acc[0], r_[1] - acc[1], r_[2] - acc[2], r_[3] - acc[3]); }
        } }
    if (!U.isctx) {
        { const f32x4 acc = mm2(FTRY(SV, 0), xBKR, ZERO4) - mm2(frow(F, QQ, tbb), xBBR, ZERO4);
          if (DIR == 0) hc0 = acc; else { const f32x4 hv = hc0 + acc; stg4(Hb + (size_t)a_ * 512 + 16 * tbb + F.bq, hv[0], hv[1], hv[2], hv[3]); } }
        asm volatile("" ::: "memory");
        { const f32x4 acc = mm2(FTRY(SV, 1), xBKR, ZERO4) - mm2(frow(F, QQ, tbb + 1), xBBR, ZERO4);
          if (DIR == 0) hc1 = acc; else { const f32x4 hv = hc1 + acc; stg4(Hb + (size_t)a_ * 512 + 16 * (tbb + 1) + F.bq, hv[0], hv[1], hv[2], hv[3]); } }
    }
}

__device__ __forceinline__ void tanh8(float (&v)[8]) {
#pragma unroll
    for (int j = 0; j < 8; ++j) { const float e = __expf(2.0f * v[j]); v[j] = 1.0f - 2.0f * __builtin_amdgcn_rcpf(e + 1.0f); }
}
__device__ __forceinline__ void rwkv_phase(const KCtx& X0) {
    const bf16* Pb = (const bf16*)(X0.a->ws + WS_P); const float* mu = X0.a->in[IN_MU];
    const bf16* W2T = (const bf16*)(X0.a->ws + WS_W2T); const bf16* A2T = (const bf16*)(X0.a->ws + WS_A2T); const bf16* G2T = (const bf16*)(X0.a->ws + WS_G2T);
    int u = X0.vcu;
    if (u >= 16 * NCHUNK) return;
    v4u pr, pk, pv; DirIn d0;
    { const KCtx& X = X0; RW_BUFS;
      const UnitGeo U = unit_geo(u); const int tok = X0.tid >> 3, sub = X0.tid & 7, hb = U.h * 64; Raw5 R; float v[8];
      for (int i = X0.tid; i < 768; i += NTHR) { const int c = i < 192 ? (i >> 6) * 512 + hb + (i & 63) : i < 576 ? C_LW + (i - 192) : (((i - 576) >> 6) * 512 + hb + ((i - 576) & 63)); MUL[i] = mu[c]; }
      __syncthreads();
      raw_issue(R, Pb, U.b, U.isctx, U.t0 + tok, C_R + hb + 8 * sub); raw_finish(R, U.isctx, MUL + 8 * sub, v); pr = pack8(v);
      raw_issue(R, Pb, U.b, U.isctx, U.t0 + tok, C_K + hb + 8 * sub); raw_finish(R, U.isctx, MUL + 64 + 8 * sub, v); pk = pack8(v);
      raw_issue(R, Pb, U.b, U.isctx, U.t0 + tok, C_V + hb + 8 * sub); raw_finish(R, U.isctx, MUL + 128 + 8 * sub, v); pv = pack8(v);
      raw_issue(R, Pb, U.b, U.isctx, U.t0 + tok, C_LW + 8 * sub); raw_finish(R, U.isctx, MUL + 192 + 8 * sub, v); tanh8(v); d0.lw = pack8(v);
      raw_issue(R, Pb, U.b, U.isctx, U.t0 + tok, C_LA + 8 * sub); raw_finish(R, U.isctx, MUL + 320 + 8 * sub, v); d0.la = pack8(v);
      d0.w2 = *(const v4u*)(W2T + (size_t)(hb + tok) * 64 + 8 * sub); d0.a2 = *(const v4u*)(A2T + (size_t)(hb + tok) * 64 + 8 * sub);
      __syncthreads(); }
#pragma unroll 1
    for (; u < 16 * NCHUNK; u += X0.G) {
        KCtx X = X0; { int t_ = X0.tid; asm volatile("" : "+v"(t_)); X.tid = t_; X.lane = t_ & 63; }
        RW_BUFS; TACC_RESET();
        const UnitGeo U = unit_geo(u); const int tok = X.tid >> 3, sub = X.tid & 7, hb = U.h * 64;
        const int un = u + X.G; const bool has_next = un < 16 * NCHUNK; const UnitGeo UN = unit_geo(has_next ? un : u); const int hbn = UN.h * 64;
        FragOff F; fragoff_init(F, X.lane, X.wave);
        { stv(SR, tok, sub, pr); stv(SK, tok, sub, pk); stv(SV, tok, sub, pv);
          float v[8]; unpack8(pk, v); float ss = 0.f;
#pragma unroll
          for (int j = 0; j < 8; ++j) { v[j] *= X.a->in[IN_KK][hb + 8 * sub + j]; ss += v[j] * v[j]; }
          ss += __shfl_xor(ss, 1); ss += __shfl_xor(ss, 2); ss += __shfl_xor(ss, 4);
          const float inv = 1.0f / fmaxf(sqrtf(ss), 1e-12f);
#pragma unroll
          for (int j = 0; j < 8; ++j) v[j] *= inv;
          store8(SKK, tok, sub, v);
          dir_s1_store(X, d0);
          if (X.tid < 384) { const int w = X.tid >> 6, n = X.tid & 63;
              PRM[X.tid] = w == 0 ? X.a->in[IN_W0][hb + n] : w == 1 ? X.a->in[IN_W0][512 + hb + n] : w == 2 ? X.a->in[IN_A0][hb + n] : w == 3 ? X.a->in[IN_A0][512 + hb + n] : w == 4 ? X.a->in[IN_KA][hb + n] : X.a->in[IN_RK][hb + n]; }
          for (int i = X.tid; i < 768; i += NTHR) { const int c = i < 192 ? (i >> 6) * 512 + hb + (i & 63) : i < 576 ? C_LW + (i - 192) : (((i - 576) >> 6) * 512 + hbn + ((i - 576) & 63)); MUL[i] = mu[c]; } }
        Raw5 R1, R2; DirIn d1; f32x4 hc0 = ZERO4, hc1 = ZERO4;
        raw_issue(R1, Pb, U.b, U.isctx, U.t0 + tok, C_LW + 64 + 8 * sub); raw_issue(R2, Pb, U.b, U.isctx, U.t0 + tok, C_LA + 64 + 8 * sub);
        d1.w2 = *(const v4u*)(W2T + (size_t)(512 + hb + tok) * 64 + 8 * sub); d1.a2 = *(const v4u*)(A2T + (size_t)(512 + hb + tok) * 64 + 8 * sub);
        __syncthreads(); TACC(0);
        dir_s2<0>(X, F); __syncthreads(); TACC(2);
        dir_s3<0>(X); __syncthreads(); TACC(3);
        dir_s4<0>(X, F); __syncthreads(); TACC(4);
        dir_s5(X, F); __syncthreads(); TACC(5);
        { float v[8]; raw_finish(R1, U.isctx, MUL + 256 + 8 * sub, v); tanh8(v); d1.lw = pack8(v); raw_finish(R2, U.isctx, MUL + 384 + 8 * sub, v); d1.la = pack8(v); }
        dir_neu(X, F, MA, PA, MB, PB, true); __syncthreads(); dir_neu(X, F, MB, PB, MA, PA, true); __syncthreads(); dir_neu(X, F, MA, PA, MB, PB, true); __syncthreads();
        dir_neu(X, F, MB, PB, MA, PA, true); __syncthreads(); dir_neu(X, F, MA, PA, MB, PB, false); __syncthreads(); TACC(6);
        dir_s6(X, F); __syncthreads(); TACC(7);
        dir_s7<0>(X, F, U, hc0, hc1); __syncthreads(); TACC(8);
        dir_s1_store(X, d1);
        v4u glg0 = {0u, 0u, 0u, 0u}, glg1 = glg0, gw0 = glg0, gw1 = glg0;
        if (!U.isctx) { raw_issue(R1, Pb, U.b, false, U.t0 + tok, C_LG + 8 * sub); raw_issue(R2, Pb, U.b, false, U.t0 + tok, C_LG + 64 + 8 * sub);
            gw0 = *(const v4u*)(G2T + (size_t)(hb + tok) * 128 + 8 * sub); gw1 = *(const v4u*)(G2T + (size_t)(hb + tok) * 128 + 64 + 8 * sub); }
        __syncthreads(); TACC(1);
        dir_s2<1>(X, F); __syncthreads(); TACC(2);
        dir_s3<1>(X); __syncthreads(); TACC(3);
        if (!U.isctx) { float v[8]; raw_finish(R1, false, MUL + 448 + 8 * sub, v);
#pragma unroll
            for (int j = 0; j < 8; ++j) v[j] = sigm(v[j]);
            glg0 = pack8(v); raw_finish(R2, false, MUL + 512 + 8 * sub, v);
#pragma unroll
            for (int j = 0; j < 8; ++j) v[j] = sigm(v[j]);
            glg1 = pack8(v); }
        Raw5 R3;
#if PF_NEXT_RKV
        if (has_next) { raw_issue(R1, Pb, UN.b, UN.isctx, UN.t0 + tok, C_R + hbn + 8 * sub); raw_issue(R2, Pb, UN.b, UN.isctx, UN.t0 + tok, C_K + hbn + 8 * sub); raw_issue(R3, Pb, UN.b, UN.isctx, UN.t0 + tok, C_V + hbn + 8 * sub); }
#endif
        dir_s4<1>(X, F); __syncthreads(); TACC(4);
        dir_s5(X, F); __syncthreads(); TACC(5);
        dir_neu(X, F, MA, PA, MB, PB, true); __syncthreads(); dir_neu(X, F, MB, PB, MA, PA, true); __syncthreads(); dir_neu(X, F, MA, PA, MB, PB, true); __syncthreads();
        dir_neu(X, F, MB, PB, MA, PA, true); __syncthreads(); dir_neu(X, F, MA, PA, MB, PB, false); __syncthreads(); TACC(6);
#if PF_NEXT_RKV
        if (has_next) { float v[8]; raw_finish(R1, UN.isctx, MUL + 576 + 8 * sub, v); pr = pack8(v); raw_finish(R2, UN.isctx, MUL + 640 + 8 * sub, v); pk = pack8(v); raw_finish(R3, UN.isctx, MUL + 704 + 8 * sub, v); pv = pack8(v); }
#endif
        if (has_next) { raw_issue(R1, Pb, UN.b, UN.isctx, UN.t0 + tok, C_LW + 8 * sub); raw_issue(R2, Pb, UN.b, UN.isctx, UN.t0 + tok, C_LA + 8 * sub);
            d0.w2 = *(const v4u*)(W2T + (size_t)(hbn + tok) * 64 + 8 * sub); d0.a2 = *(const v4u*)(A2T + (size_t)(hbn + tok) * 64 + 8 * sub); }
        dir_s6(X, F); __syncthreads(); TACC(7);
        dir_s7<1>(X, F, U, hc0, hc1); __syncthreads(); TACC(8);
        if (!U.isctx) {
            LAS bf16 *SLG0 = BUF(4), *SLG1 = BUF(5), *G2h0 = BUF(6), *G2h1 = BUF(7);
            stv(SLG0, tok, sub, glg0); stv(SLG1, tok, sub, glg1); stv(G2h0, tok, sub, gw0); stv(G2h1, tok, sub, gw1);
            __syncthreads();
            bf16* BV = (bf16*)(X.a->ws + WS_BV) + ((size_t)(U.b * T + U.t0)) * 512 + hb; bf16* GG = (bf16*)(X.a->ws + WS_GG) + ((size_t)(U.b * T + U.t0)) * 512 + hb;
            { const int ta = X.wave & 3, a_ = F.a_; const Frag2 x0 = frow(F, SLG0, ta), x1 = frow(F, SLG1, ta);
              const float bon = BON[a_];
#pragma unroll
              for (int tt = 0; tt < 2; ++tt) { const int tb = 2 * (X.wave >> 2) + tt, b0_ = 16 * tb + F.bq;
                  const f32x4 acc = mm2(frow(F, G2h1, tb), x1, mm2(frow(F, G2h0, tb), x0, ZERO4));
                  const f32x4 vv = ld4o(SV, (F.so0 ^ (16 * tt)));
                  stg4(GG + (size_t)a_ * 512 + b0_, acc[0], acc[1], acc[2], acc[3]); stg4(BV + (size_t)a_ * 512 + b0_, bon * vv[0], bon * vv[1], bon * vv[2], bon * vv[3]); } }
        }
        if (has_next) { float v[8]; raw_finish(R1, UN.isctx, MUL + 192 + 8 * sub, v); tanh8(v); d0.lw = pack8(v); raw_finish(R2, UN.isctx, MUL + 320 + 8 * sub, v); d0.la = pack8(v);
#if !PF_NEXT_RKV
            raw_issue(R1, Pb, UN.b, UN.isctx, UN.t0 + tok, C_R + hbn + 8 * sub); raw_issue(R2, Pb, UN.b, UN.isctx, UN.t0 + tok, C_K + hbn + 8 * sub); raw_issue(R3, Pb, UN.b, UN.isctx, UN.t0 + tok, C_V + hbn + 8 * sub);
            raw_finish(R1, UN.isctx, MUL + 576 + 8 * sub, v); pr = pack8(v); raw_finish(R2, UN.isctx, MUL + 640 + 8 * sub, v); pk = pack8(v); raw_finish(R3, UN.isctx, MUL + 704 + 8 * sub, v); pv = pack8(v);
#endif
        }
        __syncthreads(); TACC(9);
    }
}

#define RAW_BARRIER() do { asm volatile("s_waitcnt lgkmcnt(0)" ::: "memory"); __builtin_amdgcn_s_barrier(); asm volatile("" ::: "memory"); } while (0)
__device__ __forceinline__ void rwkv_scan(const KCtx& X, int chain) {
    LAS bf16* SB0 = BUF(0); LAS bf16* SB1 = BUF(1);
    const bf16* PP_ = (const bf16*)(X.a->ws + WS_PHIPSI) + (size_t)chain * NCHUNK * 8192;
    bf16* Sc = (bf16*)X.a->out + 16 * MiB + (size_t)chain * 128 * 4096;
    int ln_ = X.lane; asm volatile("" : "+v"(ln_));
    const int ta_ = X.wave & 3, a_ = 16 * ta_ + (ln_ & 15), tb0 = 2 * (X.wave >> 2), bq = 4 * (ln_ >> 4);
    const int srow = ln_ >> 3, schunk = (ln_ & 7) ^ (ln_ >> 3);
#define SCAN_DMA(blk, slot) do { _Pragma("unroll") for (int pi_ = 0; pi_ < 8; ++pi_) { const int p_ = X.wave + 8 * pi_; \
        const bf16* g_ = PP_ + ((size_t)(4 * (blk)) * 8192) + (size_t)(p_ >> 3) * 4096 + (8 * (p_ & 7) + srow) * 64 + 8 * schunk; \
        __builtin_amdgcn_global_load_lds((const unsigned*)g_, (LAS unsigned*)(X.lds + 2 * LB + (slot) * 65536 + p_ * 1024), 16, 0, 0); } } while (0)
    { const v4u z = {0u, 0u, 0u, 0u}; *(LAS v4u*)(SB0 + X.tid * 8) = z; }
    SCAN_DMA(0, 0);
    asm volatile("s_waitcnt vmcnt(0)" ::: "memory"); RAW_BARRIER();
#pragma unroll 1
    for (int blk = 0; blk < 33; ++blk) {
        if (blk + 1 < 33) SCAN_DMA(blk + 1, (blk + 1) & 1);
        const LAS unsigned char* slot = X.lds + 2 * LB + (blk & 1) * 65536;
#pragma unroll
        for (int j = 0; j < 4; ++j) {
            const int s = 4 * blk + j;
            LAS bf16* Scur = (j & 1) ? SB1 : SB0; LAS bf16* Snxt = (j & 1) ? SB0 : SB1;
            const LAS bf16* Pcur = (const LAS bf16*)(slot + j * 16384); const LAS bf16* PsiL = Pcur + 4096;
            if (s < NCHUNK - 1) {
                const bf16x8 x0 = fr_row(Scur, 16 * ta_, 0, ln_), x1 = fr_row(Scur, 16 * ta_, 1, ln_);
#pragma unroll
                for (int tt = 0; tt < 2; ++tt) { const int tb = tb0 + tt, b0_ = 16 * tb + bq;
                    f32x4 acc = ld4(PsiL, a_, b0_);
                    acc = __builtin_amdgcn_mfma_f32_16x16x32_bf16(fr_row(Pcur, 16 * tb, 0, ln_), x0, acc, 0, 0, 0); acc = __builtin_amdgcn_mfma_f32_16x16x32_bf16(fr_row(Pcur, 16 * tb, 1, ln_), x1, acc, 0, 0, 0);
                    st4(Snxt, a_, b0_, acc[0], acc[1], acc[2], acc[3]);
                    if (s + 1 >= 4) stg4(Sc + (size_t)(s + 1 - 4) * 4096 + a_ * 64 + b0_, acc[0], acc[1], acc[2], acc[3]); }
            }
            if (j == 3) asm volatile("s_waitcnt vmcnt(0)" ::: "memory");
            RAW_BARRIER();
        }
    }
#undef SCAN_DMA
}

__device__ __forceinline__ void rwkv_out_pair(const KCtx& X, int pair) {
    const int wsub = X.wave >> 2;
    const bf16* Sc = (const bf16*)X.a->out + 16 * MiB; const bf16* GTb = (const bf16*)X.a->out;
#pragma unroll
    for (int i = 0; i < 8; ++i) { const int unit = 2 * pair + (i >> 2), lb = unit & 127, bh = unit >> 7, cf = bh * 2, cr = cf + 1; const int kind = i & 3;
        const bf16* src = kind == 0 ? GTb + ((size_t)cf * 128 + lb) * 4096 : kind == 1 ? GTb + ((size_t)cr * 128 + lb) * 4096 : kind == 2 ? Sc + ((size_t)cf * 128 + lb) * 4096 : Sc + ((size_t)cr * 128 + (127 - lb)) * 4096;
        const int row = X.tid >> 3, sub = X.tid & 7;
        *(LAS v4u*)(BUF(i) + row * 64 + (((sub ^ row) & 7) << 3)) = *(const v4u*)(src + row * 64 + 8 * sub); }
    __syncthreads();
    const int unit = 2 * pair + wsub, lb = unit & 127, bh = unit >> 7, b = bh >> 3, h = bh & 7, hb = h * 64, t0 = lb * 64;
    LAS bf16 *GF = BUF(4 * wsub), *GR = BUF(4 * wsub + 1), *SF = BUF(4 * wsub + 2), *SRv = BUF(4 * wsub + 3);
    int ln_ = X.lane; asm volatile("" : "+v"(ln_));
    const int ta_ = X.wave & 3, a_ = 16 * ta_ + (ln_ & 15), bq = 4 * (ln_ >> 4);
    const size_t trow = (size_t)(b * T + t0 + a_);
    const bf16* Hb = (const bf16*)(X.a->ws + WS_HB) + trow * 512 + hb; const bf16* BV = (const bf16*)(X.a->ws + WS_BV) + trow * 512 + hb; const bf16* GG = (const bf16*)(X.a->ws + WS_GG) + trow * 512 + hb;
    bf16* O = (bf16*)(X.a->ws + WS_P) + trow * PP + hb;
    const bf16x8 xf0 = fr_row(GF, 16 * ta_, 0, ln_), xf1 = fr_row(GF, 16 * ta_, 1, ln_), xr0 = fr_row(GR, 16 * ta_, 0, ln_), xr1 = fr_row(GR, 16 * ta_, 1, ln_);
    f32x4 y[4]; float s1 = 0.f;
#pragma unroll
    for (int tb = 0; tb < 4; ++tb) { const int b0_ = 16 * tb + bq; const u32x2 hv = *(const u32x2*)(Hb + b0_);
        f32x4 acc = {bf2f(hv.x & 0xffffu), bf2f(hv.x >> 16), bf2f(hv.y & 0xffffu), bf2f(hv.y >> 16)};
        acc = __builtin_amdgcn_mfma_f32_16x16x32_bf16(fr_row(SF, 16 * tb, 0, ln_), xf0, acc, 0, 0, 0); acc = __builtin_amdgcn_mfma_f32_16x16x32_bf16(fr_row(SF, 16 * tb, 1, ln_), xf1, acc, 0, 0, 0);
        acc = __builtin_amdgcn_mfma_f32_16x16x32_bf16(fr_row(SRv, 16 * tb, 0, ln_), xr0, acc, 0, 0, 0); acc = __builtin_amdgcn_mfma_f32_16x16x32_bf16(fr_row(SRv, 16 * tb, 1, ln_), xr1, acc, 0, 0, 0);
        y[tb] = acc; s1 += (acc[0] + acc[1]) + (acc[2] + acc[3]); }
    s1 += __shfl_xor(s1, 16); s1 += __shfl_xor(s1, 32);
    const float mean = s1 * (1.0f / 64.0f); float s2 = 0.f;
#pragma unroll
    for (int tb = 0; tb < 4; ++tb) { y[tb] = y[tb] - mean; s2 += (y[tb][0] * y[tb][0] + y[tb][1] * y[tb][1]) + (y[tb][2] * y[tb][2] + y[tb][3] * y[tb][3]); }
    s2 += __shfl_xor(s2, 16); s2 += __shfl_xor(s2, 32);
    const float rstd = 1.0f / sqrtf(s2 * (1.0f / 64.0f) + 64e-5f);
#pragma unroll
    for (int tb = 0; tb < 4; ++tb) { const int b0_ = 16 * tb + bq;
        const f32x4 gg = *(const f32x4*)(X.a->in[IN_GNG] + hb + b0_), gb = *(const f32x4*)(X.a->in[IN_GNB] + hb + b0_);
        const u32x2 bv = *(const u32x2*)(BV + b0_), gt = *(const u32x2*)(GG + b0_);
        const f32x4 bvf = {bf2f(bv.x & 0xffffu), bf2f(bv.x >> 16), bf2f(bv.y & 0xffffu), bf2f(bv.y >> 16)}, gtf = {bf2f(gt.x & 0xffffu), bf2f(gt.x >> 16), bf2f(gt.y & 0xffffu), bf2f(gt.y >> 16)};
        const f32x4 o = (y[tb] * rstd * gg + gb + bvf) * gtf;
        stg4(O + b0_, o[0], o[1], o[2], o[3]); }
    __syncthreads();
}
__device__ __forceinline__ float ret_lg(const KCtx& X, int d, int rh) { const float x = X.a->in[IN_RDEC][d * 4 + rh]; return -(x > 20.f ? x : log1pf(__expf(x))); }
__device__ __forceinline__ int sw128(int r, int c) { return r * 128 + ((((c >> 3) ^ (r & 7))) << 3) + (c & 7); }
__device__ __forceinline__ bf16x8 fr_row128(const LAS bf16* buf, int r0, int ks, int lane) {
    const int row = r0 + (lane & 15), ch = 4 * ks + (lane >> 4);
    return *(const LAS bf16x8*)(buf + row * 128 + ((ch ^ (row & 7)) << 3));
}
__device__ __forceinline__ bf16x8 fr_tr128(const LAS bf16* buf, int c0, int ks, int lane) {
    const int g = lane >> 4, q = (lane >> 2) & 3, p = lane & 3, col = c0 + 4 * p;
    const int k0 = 32 * ks + 8 * g + q, k1 = k0 + 4;
    const s16x4 lo = __builtin_amdgcn_ds_read_tr16_b64_v4i16((LAS s16x4*)(buf + k0 * 128 + (((col >> 3) ^ (k0 & 7)) << 3) + (col & 7)));
    const s16x4 hi = __builtin_amdgcn_ds_read_tr16_b64_v4i16((LAS s16x4*)(buf + k1 * 128 + (((col >> 3) ^ (k1 & 7)) << 3) + (col & 7)));
    return (bf16x8){lo[0], lo[1], lo[2], lo[3], hi[0], hi[1], hi[2], hi[3]};
}
__device__ __forceinline__ void st8_128(LAS bf16* buf, int r, int chunk, const float (&v)[8]) {
    v4u o; o.x = pk2(v[0], v[1]); o.y = pk2(v[2], v[3]); o.z = pk2(v[4], v[5]); o.w = pk2(v[6], v[7]);
    *(LAS v4u*)(buf + r * 128 + ((chunk ^ (r & 7)) << 3)) = o;
}
__device__ __forceinline__ void ret_load_qk(const KCtx& X, LAS bf16* dst, LAS bf16* dst2, const LAS float* w1, const LAS float* w2, size_t row0, int colbase, bool rope, int tpos0, float scale) {
    const bf16* Pb = (const bf16*)(X.a->ws + WS_P); const float* rp = (const float*)(X.a->ws + WS_ROPE);
    for (int it = X.tid; it < 1024; it += NTHR) {
        const int j = it >> 3, half = (it >> 2) & 1, pc = it & 3;
        const bf16* p = Pb + (row0 + j) * PP + colbase + half * 64 + pc * 8;
        const v4u a = *(const v4u*)p, b2 = *(const v4u*)(p + 32);
        const unsigned aw[4] = {a.x, a.y, a.z, a.w}, bw[4] = {b2.x, b2.y, b2.z, b2.w};
        float z1[8], z2[8];
#pragma unroll
        for (int w = 0; w < 4; ++w) { z1[2 * w] = bf2f(aw[w] & 0xffffu); z1[2 * w + 1] = bf2f(aw[w] >> 16); z2[2 * w] = bf2f(bw[w] & 0xffffu); z2[2 * w + 1] = bf2f(bw[w] >> 16); }
        float o1[8], o2[8];
        if (rope) { const int tp = tpos0 + j; const int pos = half ? (tp & 63) : (tp >> 6);
#pragma unroll
            for (int e = 0; e < 8; ++e) { const float cs = rp[(pos * 32 + pc * 8 + e) * 2], sn = rp[(pos * 32 + pc * 8 + e) * 2 + 1];
                o1[e] = (z1[e] * cs - z2[e] * sn) * scale; o2[e] = (z1[e] * sn + z2[e] * cs) * scale; } }
        else {
#pragma unroll
            for (int e = 0; e < 8; ++e) { o1[e] = z1[e] * scale; o2[e] = z2[e] * scale; } }
        const int ch1 = half * 8 + pc, ch2 = ch1 + 4;
        if (dst2 == nullptr) { st8_128(dst, j, ch1, o1); st8_128(dst, j, ch2, o2); }
        else { const float wa = w1[j], wb = w2[j]; float t1[8], t2[8];
#pragma unroll
            for (int e = 0; e < 8; ++e) { t1[e] = o1[e] * wa; t2[e] = o2[e] * wa; }
            st8_128(dst, j, ch1, t1); st8_128(dst, j, ch2, t2);
#pragma unroll
            for (int e = 0; e < 8; ++e) { t1[e] = o1[e] * wb; t2[e] = o2[e] * wb; }
            st8_128(dst2, j, ch1, t1); st8_128(dst2, j, ch2, t2); }
    }
}
__device__ __forceinline__ void ret_load_plain(const KCtx& X, LAS bf16* dst, const bf16* src, size_t pitch) {
    for (int it = X.tid; it < 2048; it += NTHR) { const int j = it >> 4, pc = it & 15; *(LAS v4u*)(dst + j * 128 + ((pc ^ (j & 7)) << 3)) = *(const v4u*)(src + (size_t)j * pitch + pc * 8); }
}
__device__ __forceinline__ void ret_u_unit(const KCtx& X, int unit) {
    const int ci = unit % RCH, bh = unit / RCH, b = bh >> 2, rh = bh & 3;
    const bool isctx = ci < 2; const int n = isctx ? ci : ci - 2;
    TACC_RESET();
    const size_t row0 = isctx ? (size_t)(MLAT + b * CTX + n * 128) : (size_t)(b * T + n * 128);
    LAS bf16* KF = (LAS bf16*)X.lds; LAS bf16* KR = KF + 16384; LAS bf16* V = KR + 16384;
    LAS float* WF = (LAS float*)(X.lds + 98304); LAS float* WR = WF + 128;
    const float lg0 = ret_lg(X, 0, rh), lg1 = ret_lg(X, 1, rh);
    if (X.tid < 128) { WF[X.tid] = __expf(lg0 * (float)(127 - X.tid)); WR[X.tid] = __expf(lg1 * (float)X.tid); }
    __syncthreads();
    ret_load_qk(X, KF, KR, WF, WR, row0, C_RK + rh * 128, !isctx, n * 128, 0.08838834764831845f);
    ret_load_plain(X, V, (const bf16*)(X.a->ws + WS_P) + row0 * PP + C_RV + rh * 128, PP);
    __syncthreads();
    const int sf = ci, sr = isctx ? 1 - ci : 2 + 63 - n;
    bf16* Uf = (bf16*)(X.a->ws + WS_RET) + (((size_t)(b * 4 + rh) * 2 + 0) * RCH + sf) * 16384;
    bf16* Ur = (bf16*)(X.a->ws + WS_RET) + (((size_t)(b * 4 + rh) * 2 + 1) * RCH + sr) * 16384;
    int ln_ = X.lane; asm volatile("" : "+v"(ln_));
    const int a0 = 16 * X.wave, a_ = a0 + (ln_ & 15), bq = 4 * (ln_ >> 4);
#pragma unroll
    for (int dir = 0; dir < 2; ++dir) { const LAS bf16* KW = dir ? KR : KF; bf16* U = dir ? Ur : Uf;
        bf16x8 xk[4];
#pragma unroll
        for (int ks = 0; ks < 4; ++ks) xk[ks] = fr_tr128(KW, a0, ks, ln_);
#pragma unroll 2
        for (int tb = 0; tb < 8; ++tb) { f32x4 acc = {0.f, 0.f, 0.f, 0.f};
#pragma unroll
            for (int ks = 0; ks < 4; ++ks) acc = __builtin_amdgcn_mfma_f32_16x16x32_bf16(fr_tr128(V, 16 * tb, ks, ln_), xk[ks], acc, 0, 0, 0);
            stg4(U + a_ * 128 + 16 * tb + bq, acc[0], acc[1], acc[2], acc[3]); } }
    __syncthreads(); TACC(10);
}
__device__ __forceinline__ void ret_prefix(const KCtx& X, int worker, int nworkers) {
    unsigned* R = (unsigned*)(X.a->ws + WS_RET);
    for (int p = worker * NTHR + X.tid; p < 16 * 8192; p += nworkers * NTHR) {
        const int c = p >> 13, e = p & 8191, d = c & 1, rh = (c >> 1) & 3;
        const float g = __expf(ret_lg(X, d, rh) * 128.0f);
        unsigned* q = R + (size_t)c * RCH * 8192 + e; float s0 = 0.f, s1 = 0.f;
#pragma unroll 1
        for (int s8 = 0; s8 < RCH; s8 += 11) { unsigned u[11];
#pragma unroll
            for (int i = 0; i < 11; ++i) u[i] = q[(size_t)(s8 + i) * 8192];
#pragma unroll
            for (int i = 0; i < 11; ++i) { q[(size_t)(s8 + i) * 8192] = pk2(s0, s1); s0 = s0 * g + bf2f(u[i] & 0xffffu); s1 = s1 * g + bf2f(u[i] >> 16); } }
    }
}
__device__ __forceinline__ void ret_out_unit(const KCtx& X, int unit) {
    const int n = unit & 63, bh = unit >> 6, b = bh >> 2, rh = bh & 3;
    const size_t row0 = (size_t)(b * T + n * 128);
    LAS bf16* Q = (LAS bf16*)X.lds; LAS bf16* K = Q + 16384; LAS bf16* V = K + 16384; LAS bf16* SC = V + 16384;
    const float lg0 = ret_lg(X, 0, rh), lg1 = ret_lg(X, 1, rh);
    ret_load_qk(X, Q, nullptr, nullptr, nullptr, row0, C_RQ + rh * 128, true, n * 128, 1.0f);
    ret_load_qk(X, K, nullptr, nullptr, nullptr, row0, C_RK + rh * 128, true, n * 128, 0.08838834764831845f);
    ret_load_plain(X, V, (const bf16*)(X.a->ws + WS_P) + row0 * PP + C_RV + rh * 128, PP);
    __syncthreads();
    int ln_ = X.lane; asm volatile("" : "+v"(ln_));
    const int a0 = 16 * X.wave, a_ = a0 + (ln_ & 15), bq = 4 * (ln_ >> 4);
    bf16x8 xq[4];
#pragma unroll
    for (int ks = 0; ks < 4; ++ks) xq[ks] = fr_row128(Q, a0, ks, ln_);
#pragma unroll 2
    for (int tb = 0; tb < 8; ++tb) { f32x4 acc = {0.f, 0.f, 0.f, 0.f};
#pragma unroll
        for (int ks = 0; ks < 4; ++ks) acc = __builtin_amdgcn_mfma_f32_16x16x32_bf16(fr_row128(K, 16 * tb, ks, ln_), xq[ks], acc, 0, 0, 0);
        float o[4];
#pragma unroll
        for (int i = 0; i < 4; ++i) { const int j = 16 * tb + bq + i; o[i] = acc[i] * (j <= a_ ? __expf(lg0 * (float)(a_ - j)) : __expf(lg1 * (float)(j - a_))); }
        u32x2 w; w.x = pk2(o[0], o[1]); w.y = pk2(o[2], o[3]); *(LAS u32x2*)(SC + sw128(a_, 16 * tb + bq)) = w; }
    __syncthreads();
    const bf16* Sf = (const bf16*)(X.a->ws + WS_RET) + (((size_t)(b * 4 + rh) * 2 + 0) * RCH + (2 + n)) * 16384;
    const bf16* Sr = (const bf16*)(X.a->ws + WS_RET) + (((size_t)(b * 4 + rh) * 2 + 1) * RCH + (2 + 63 - n)) * 16384;
    f32x4 y[8];
    { bf16x8 xs[4];
#pragma unroll
      for (int ks = 0; ks < 4; ++ks) xs[ks] = fr_row128(SC, a0, ks, ln_);
#pragma unroll
      for (int tb = 0; tb < 8; ++tb) { f32x4 acc = {0.f, 0.f, 0.f, 0.f};
#pragma unroll
          for (int ks = 0; ks < 4; ++ks) acc = __builtin_amdgcn_mfma_f32_16x16x32_bf16(fr_tr128(V, 16 * tb, ks, ln_), xs[ks], acc, 0, 0, 0);
          y[tb] = acc; } }
#pragma unroll 1
    for (int dir = 0; dir < 2; ++dir) {
        ret_load_plain(X, K, dir ? Sr : Sf, 128);
        __syncthreads();
        const float cc = dir ? __expf(lg1 * (float)(128 - a_)) : __expf(lg0 * (float)(a_ + 1));
#pragma unroll
        for (int tb = 0; tb < 8; ++tb) { f32x4 acc = {0.f, 0.f, 0.f, 0.f};
#pragma unroll
            for (int ks = 0; ks < 4; ++ks) acc = __builtin_amdgcn_mfma_f32_16x16x32_bf16(fr_tr128(K, 16 * tb, ks, ln_), xq[ks], acc, 0, 0, 0);
            y[tb] = y[tb] + acc * cc; }
        __syncthreads();
    }
    float s1 = 0.f;
#pragma unroll
    for (int tb = 0; tb < 8; ++tb) s1 += (y[tb][0] + y[tb][1]) + (y[tb][2] + y[tb][3]);
    s1 += __shfl_xor(s1, 16); s1 += __shfl_xor(s1, 32);
    const float mean = s1 * (1.0f / 128.0f); float s2 = 0.f;
#pragma unroll
    for (int tb = 0; tb < 8; ++tb) { y[tb] = y[tb] - mean; s2 += (y[tb][0] * y[tb][0] + y[tb][1] * y[tb][1]) + (y[tb][2] * y[tb][2] + y[tb][3] * y[tb][3]); }
    s2 += __shfl_xor(s2, 16); s2 += __shfl_xor(s2, 32);
    const float rstd = 1.0f / sqrtf(s2 * (1.0f / 128.0f) + 1e-5f);
    const bf16* Pb = (const bf16*)(X.a->ws + WS_P) + (row0 + a_) * PP;
    bf16* O = (bf16*)(X.a->ws + WS_P) + (row0 + a_) * PP + 512 + rh * 128;
#pragma unroll
    for (int tb = 0; tb < 8; ++tb) { const int c = rh * 128 + 16 * tb + bq;
        const f32x4 gg = *(const f32x4*)(X.a->in[IN_RGNG] + c), gb = *(const f32x4*)(X.a->in[IN_RGNB] + c);
        const u32x2 gw = *(const u32x2*)(Pb + C_RG + c);
        const f32x4 gt = {bf2f(gw.x & 0xffffu), bf2f(gw.x >> 16), bf2f(gw.y & 0xffffu), bf2f(gw.y >> 16)};
        f32x4 o = y[tb] * rstd * gg + gb;
#pragma unroll
        for (int i = 0; i < 4; ++i) o[i] = o[i] * gt[i] * sigm(gt[i]);
        stg4(O + 16 * tb + bq, o[0], o[1], o[2], o[3]); }
    __syncthreads();
}
__device__ __forceinline__ void moe_convert(const KCtx& X) {
    LAS float* scr = (LAS float*)(X.lds + X.wave * 8704);
    const int gw = X.vcu * NWAVES + X.wave, NGW = X.G * NWAVES;
    bf16* WguT = (bf16*)(X.a->ws + WS_WGU); bf16* WdT = (bf16*)(X.a->ws + WS_WD);
    constexpr int IGU = 16 * 16, IDN = 8 * 32;
    for (int it = gw; it < 32 * (2 * IGU + IDN); it += NGW) {
        const int e = it / (2 * IGU + IDN); int r = it % (2 * IGU + IDN);
        if (r < 2 * IGU) { const int up = r >= IGU; if (up) r -= IGU; const int nb = r % 16, n0 = nb * 32, pnl = n0 >> 7;
            transpose_item((up ? X.a->in[IN_EWU] : X.a->in[IN_EWG]) + (size_t)e * 1024 * 512, 1024, 512, WguT, e * 1024 + pnl * 128 + up * 128, scr, r, X.lane); }
        else { r -= 2 * IGU; transpose_item(X.a->in[IN_EWD] + (size_t)e * 512 * 1024, 512, 1024, WdT, e * 1024, scr, r, X.lane); }
    }
}
__device__ __forceinline__ float dot16(const f32x4 (&u)[4], const LAS float* w, int lane) {
    float p = 0.f;
#pragma unroll
    for (int j = 0; j < 4; ++j) { const f32x4 x = *(const LAS f32x4*)(w + 4 * lane + 256 * j); p += (u[j].x * x.x + u[j].y * x.y) + (u[j].z * x.z + u[j].w * x.w); }
    return p;
}
__device__ __forceinline__ void moe_route(const KCtx& X) {
    const float* mod = (const float*)(X.a->ws + WS_MOD); const float* RTt = (const float*)(X.a->ws + WS_RT);
    bf16* U2 = (bf16*)(X.a->ws + WS_U2);
    int* toke = (int*)(X.a->ws + WS_ROUTE + RT_TOKE); int* tokpos = (int*)(X.a->ws + WS_ROUTE + RT_TOKPOS); float* tokgate = (float*)(X.a->ws + WS_ROUTE + RT_TOKGATE);
    int* wgcnt = (int*)(X.a->ws + WS_ROUTE + RT_WGCNT);
    LAS float* RL = (LAS float*)X.lds;
    LAS unsigned* lcnt = (LAS unsigned*)(X.lds + L_MISC);
    __syncthreads();
    if (X.tid < 32) lcnt[X.tid] = 0u;
    for (int i = X.tid; i < 36 * 256; i += NTHR) *(LAS f32x4*)(RL + 4 * i) = *(const f32x4*)(RTt + 4 * i);
    __syncthreads();
    const int tpw = MLAT / X.G;
    for (int m = X.vcu * tpw + X.wave; m < (X.vcu + 1) * tpw; m += NWAVES) {
        float* zr = X.a->out + (size_t)m * D; const float* mr = mod + (m >> 13) * 6144;
        f32x4 v[4]; float s = 0.f;
#pragma unroll
        for (int j = 0; j < 4; ++j) { v[j] = *(const f32x4*)(zr + 4 * X.lane + 256 * j); s += (v[j].x + v[j].y) + (v[j].z + v[j].w); }
        const float mean = wave_sum(s) * (1.f / D); float s2 = 0.f;
#pragma unroll
        for (int j = 0; j < 4; ++j) { v[j] = v[j] - mean; s2 += (v[j].x * v[j].x + v[j].y * v[j].y) + (v[j].z * v[j].z + v[j].w * v[j].w); }
        const float rstd = 1.f / sqrtf(wave_sum(s2) * (1.f / D) + LN_EPS);
        f32x4 u[4];
#pragma unroll
        for (int j = 0; j < 4; ++j) { const int c = 4 * X.lane + 256 * j;
            const f32x4 g = *(const f32x4*)(X.a->in[IN_LN1G] + c), bb = *(const f32x4*)(X.a->in[IN_LN1B] + c), sh = *(const f32x4*)(mr + 3072 + c), sc = *(const f32x4*)(mr + 4096 + c);
            const f32x4 h = v[j] * rstd * g + bb; *(f32x4*)(zr + c) = h; u[j] = h * (sc + 1.0f) + sh;
            *(unsigned long long*)(U2 + (size_t)m * D + c) = (unsigned long long)pk2(u[j].x, u[j].y) | ((unsigned long long)pk2(u[j].z, u[j].w) << 32); }
        float gp[4];
#pragma unroll
        for (int g = 0; g < 4; ++g) gp[g] = dot16(u, RL + g * 1024, X.lane);
#pragma unroll
        for (int o = 1; o < 64; o <<= 1) {
#pragma unroll
            for (int g = 0; g < 4; ++g) gp[g] += __shfl_xor(gp[g], o); }
        float gmax = -3.0e38f; int gi = 0;
#pragma unroll
        for (int g = 0; g < 4; ++g) { gp[g] += X.a->in[IN_RGB][g]; if (gp[g] > gmax) { gmax = gp[g]; gi = g; } }
        float gsum = 0.f;
#pragma unroll
        for (int g = 0; g < 4; ++g) gsum += __expf(gp[g] - gmax);
        const float gw_ = 1.0f / gsum;
        gi = __builtin_amdgcn_readfirstlane(gi);
        const LAS float* rte = RL + (4 + gi * 8) * 1024;
        float ep[8];
#pragma unroll
        for (int i = 0; i < 8; ++i) ep[i] = dot16(u, rte + i * 1024, X.lane);
#pragma unroll
        for (int o = 1; o < 64; o <<= 1) {
#pragma unroll
            for (int i = 0; i < 8; ++i) ep[i] += __shfl_xor(ep[i], o); }
        float m1 = -3.0e38f, m2 = -3.0e38f; int i1 = 0, i2 = 0;
#pragma unroll
        for (int i = 0; i < 8; ++i) { const float l = ep[i] + X.a->in[IN_REB][gi * 8 + i];
            if (l > m1) { m2 = m1; i2 = i1; m1 = l; i1 = i; } else if (l > m2) { m2 = l; i2 = i; } }
        const float e2 = __expf(m2 - m1); const float ga = gw_ / (1.0f + e2), gb = gw_ * e2 / (1.0f + e2);
        if (X.lane == 0) { const int ea = gi * 8 + i1, eb = gi * 8 + i2;
            const unsigned pa = __hip_atomic_fetch_add(lcnt + ea, 1u, __ATOMIC_RELAXED, __HIP_MEMORY_SCOPE_WORKGROUP), pb = __hip_atomic_fetch_add(lcnt + eb, 1u, __ATOMIC_RELAXED, __HIP_MEMORY_SCOPE_WORKGROUP);
            toke[2 * m] = ea; toke[2 * m + 1] = eb; tokpos[2 * m] = (int)pa; tokpos[2 * m + 1] = (int)pb; tokgate[2 * m] = ga; tokgate[2 * m + 1] = gb; }
    }
    __syncthreads();
    if (X.tid < 32) wgcnt[X.vcu * 32 + X.tid] = (int)lcnt[X.tid];
}
__device__ __forceinline__ int moe_tiles(const KCtx& X, LAS int* tile_e, LAS int* pstart) {
    const int* cnt = (const int*)(X.a->ws + WS_ROUTE + RT_CNT);
    if (X.tid == 0) { int acc = 0; for (int e = 0; e < 32; ++e) { const int c = cnt[e]; const int nt = (c + 255) >> 8; pstart[e] = acc * 256; for (int t = 0; t < nt; ++t) tile_e[acc + t] = e; acc += nt; } pstart[32] = acc; }
    __syncthreads();
    return pstart[32];
}
__device__ __forceinline__ void moe_gather(const KCtx& X) {
    LAS int* tile_e = (LAS int*)(X.lds + L_MISC); LAS int* pstart = tile_e + 256;
    LAS int* tot = pstart + 64; LAS int* base = tot + 32; LAS int* part = (LAS int*)X.lds;
    const int* wgcnt = (const int*)(X.a->ws + WS_ROUTE + RT_WGCNT);
    { const int e = X.tid & 31, pr = X.tid >> 5; int st = 0, sb = 0;
      for (int o = pr; o < X.G; o += 16) { const int c = wgcnt[o * 32 + e]; st += c; if (o < X.vcu) sb += c; }
      part[(pr * 2 + 0) * 32 + e] = st; part[(pr * 2 + 1) * 32 + e] = sb; }
    __syncthreads();
    if (X.tid < 32) { int st = 0, sb = 0; for (int pr = 0; pr < 16; ++pr) { st += part[(pr * 2) * 32 + X.tid]; sb += part[(pr * 2 + 1) * 32 + X.tid]; } tot[X.tid] = st; base[X.tid] = sb;
        if (X.vcu == 0) ((int*)(X.a->ws + WS_ROUTE + RT_CNT))[X.tid] = st; }
    __syncthreads();
    if (X.tid == 0) { int acc = 0; for (int e = 0; e < 32; ++e) { pstart[e] = acc * 256; acc += (tot[e] + 255) >> 8; } pstart[32] = acc; }
    __syncthreads();
    const bf16* U2 = (const bf16*)(X.a->ws + WS_U2); bf16* Xs = (bf16*)(X.a->ws + WS_XS);
    const int* toke = (const int*)(X.a->ws + WS_ROUTE + RT_TOKE); const int* tokpos = (const int*)(X.a->ws + WS_ROUTE + RT_TOKPOS); const float* tokgate = (const float*)(X.a->ws + WS_ROUTE + RT_TOKGATE);
    int* tokslot = (int*)(X.a->ws + WS_ROUTE + RT_TOKSLOT); float* sgate = (float*)(X.a->ws + WS_ROUTE + RT_SGATE);
    const int tpw = MLAT / X.G;
    for (int m = X.vcu * tpw + X.wave; m < (X.vcu + 1) * tpw; m += NWAVES) {
        const v4u a = *(const v4u*)(U2 + (size_t)m * D + 8 * X.lane), b2 = *(const v4u*)(U2 + (size_t)m * D + 512 + 8 * X.lane);
#pragma unroll
        for (int k = 0; k < 2; ++k) { const int e = toke[2 * m + k]; const int slot = pstart[e] + base[e] + tokpos[2 * m + k];
            *(v4u*)(Xs + (size_t)slot * D + 8 * X.lane) = a; *(v4u*)(Xs + (size_t)slot * D + 512 + 8 * X.lane) = b2;
            if (X.lane == 0) { tokslot[2 * m + k] = slot; sgate[slot] = tokgate[2 * m + k]; } }
    }
}
__device__ __forceinline__ void moe_final(const KCtx& X) {
    const float* mod = (const float*)(X.a->ws + WS_MOD); const bf16* Ys = (const bf16*)(X.a->ws + WS_XS); const int* tokslot = (const int*)(X.a->ws + WS_ROUTE + RT_TOKSLOT);
    const int gw = X.vcu * NWAVES + X.wave, NGW = X.G * NWAVES;
    for (int m = gw; m < MLAT; m += NGW) {
        float* hr = X.a->out + (size_t)m * D; const float* g2 = mod + (m >> 13) * 6144 + 5120;
        const bf16* y0 = Ys + (size_t)tokslot[2 * m] * D; const bf16* y1 = Ys + (size_t)tokslot[2 * m + 1] * D;
        f32x4 v[4]; float s = 0.f;
#pragma unroll
        for (int j = 0; j < 4; ++j) { const int c = 4 * X.lane + 256 * j; const f32x4 h = *(const f32x4*)(hr + c), gg = *(const f32x4*)(g2 + c);
            const unsigned long long a = *(const unsigned long long*)(y0 + c), b2 = *(const unsigned long long*)(y1 + c);
            f32x4 f; f.x = bf2f((unsigned)a & 0xffffu) + bf2f((unsigned)b2 & 0xffffu); f.y = bf2f(((unsigned)a) >> 16) + bf2f(((unsigned)b2) >> 16);
            f.z = bf2f((unsigned)(a >> 32) & 0xffffu) + bf2f((unsigned)(b2 >> 32) & 0xffffu); f.w = bf2f((unsigned)(a >> 48)) + bf2f((unsigned)(b2 >> 48));
            v[j] = h * ALPHA + gg * f; s += (v[j].x + v[j].y) + (v[j].z + v[j].w); }
        const float mean = wave_sum(s) * (1.f / D); float s2 = 0.f;
#pragma unroll
        for (int j = 0; j < 4; ++j) { v[j] = v[j] - mean; s2 += (v[j].x * v[j].x + v[j].y * v[j].y) + (v[j].z * v[j].z + v[j].w * v[j].w); }
        const float rstd = 1.f / sqrtf(wave_sum(s2) * (1.f / D) + LN_EPS);
#pragma unroll
        for (int j = 0; j < 4; ++j) { const int c = 4 * X.lane + 256 * j; const f32x4 g = *(const f32x4*)(X.a->in[IN_LN2G] + c), bb = *(const f32x4*)(X.a->in[IN_LN2B] + c);
            *(f32x4*)(hr + c) = v[j] * rstd * g + bb; }
    }
}
__global__ void __launch_bounds__(NTHR, 2) fwd_kernel(Args args) {
    extern __shared__ __attribute__((aligned(16))) unsigned char lds_raw[];
    KCtx X;
    X.lds = (LAS unsigned char*)lds_raw;
    X.tid = threadIdx.x; X.lane = X.tid & 63; X.wave = __builtin_amdgcn_readfirstlane(X.tid >> 6);
    X.G = gridDim.x; { const int bx = blockIdx.x; X.vcu = (X.G % 8 == 0) ? (bx % 8) * (X.G / 8) + bx / 8 : bx; }
    X.a = &args;
    volatile LAS unsigned* CTLW = (volatile LAS unsigned*)(X.lds + L_CTL);
    for (int u = X.tid; u < 128; u += NTHR) CTLW[u] = 0u;
    __syncthreads();
    XcdBarrier bar; bar.bar = (unsigned*)(X.a->ws + WS_CTL) + CW_BAR; bar.x = 0; bar.st = nullptr;
    if (N_LAUNCHES == 1) bar = xcd_barrier_post((unsigned*)(X.a->ws + WS_CTL) + CW_BAR, CTLW + 8);
    const int lo = args.ph_lo, hi = args.ph_hi;
#ifndef PHMASK
#define PHMASK 0xFFF
#endif
#define IN(k) (((PHMASK >> (k)) & 1) && lo <= (k) && (k) < hi)
#ifndef PROBE_A
#define SEAM(k) do { if (IN(k) && IN((k) + 1)) xcd_barrier(bar); } while (0)
#endif

#ifdef PROBE_A
    volatile LAS unsigned long long* STAMP = (volatile LAS unsigned long long*)(X.lds + L_CTL + 256);
    int nstamp = 0;
#define SEAM(k) do { if (IN(k) && IN((k) + 1)) xcd_barrier(bar); if (blockIdx.x == 0 && X.tid == 0) STAMP[++nstamp] = __builtin_amdgcn_s_memrealtime(); } while (0)
    if (blockIdx.x == 0 && X.tid == 0) STAMP[0] = __builtin_amdgcn_s_memrealtime();
#endif
    if (IN(0)) { phase0(X); } SEAM(0);
    if (IN(1)) { phase1(X); } SEAM(1);
    if (IN(2)) {
        pg8::Gemm g{(const bf16*)(X.a->ws + WS_U), (const bf16*)(X.a->ws + WS_WIN), MALL, PP, D, D}; pg8::StaticOrder S; S.init(MALL, PP, X.G, (int)blockIdx.x);
        pg8::EpiBf16 E{(bf16*)(X.a->ws + WS_P), PP};
        pg8::gemm_phase<pg8::EpiBf16, pg8::StaticOrder, true, true>(X.lds, g, S, E);
    } SEAM(2);
    if (IN(3)) {
        rwkv_phase(X);
        for (int u = X.vcu + ((16 * NCHUNK - X.vcu + X.G - 1) / X.G) * X.G; u < 16 * NCHUNK + 8 * RCH; u += X.G) { KCtx Y = X; { int t_ = X.tid; asm volatile("" : "+v"(t_)); Y.tid = t_; Y.lane = t_ & 63; }
            ret_u_unit(Y, u - 16 * NCHUNK); }
    } SEAM(3);
    if (IN(4)) {
        if (X.G >= 64) { if (X.vcu < 32) rwkv_scan(X, X.vcu); else ret_prefix(X, X.vcu - 32, X.G - 32); }
        else { for (int c = X.vcu; c < 32; c += X.G) rwkv_scan(X, c); ret_prefix(X, X.vcu, X.G); }
    } SEAM(4);
    if (IN(5)) {
        for (int u = X.vcu; u < 1024 + 512; u += X.G) { KCtx Y = X; { int t_ = X.tid; asm volatile("" : "+v"(t_)); Y.tid = t_; Y.lane = t_ & 63; }
            if (u < 512) ret_out_unit(Y, u); else rwkv_out_pair(Y, u - 512); }
    } SEAM(5);
    if (IN(6)) {
        pg8::Gemm g{(const bf16*)(X.a->ws + WS_P), (const bf16*)(X.a->ws + WS_WOUT), MLAT, D, D, PP}; pg8::StaticOrder S; S.init(MLAT, D, X.G, (int)blockIdx.x);
        pg8::EpiOut E{X.a->in[IN_X], (const float*)(X.a->ws + WS_STATS), X.a->in[IN_EG], X.a->in[IN_EB], (const float*)(X.a->ws + WS_MOD), X.a->out, ALPHA};
        pg8::gemm_phase<pg8::EpiOut, pg8::StaticOrder, true, true>(X.lds, g, S, E);
    } SEAM(6);
#ifdef PROBE_SPLIT7
    if (IN(7)) { moe_convert(X); xcd_barrier(bar); if (blockIdx.x == 0 && X.tid == 0) STAMP[13] = __builtin_amdgcn_s_memrealtime(); moe_route(X); } SEAM(7);
#else
    if (IN(7)) { moe_convert(X); moe_route(X); } SEAM(7);
#endif
    if (IN(8)) { moe_gather(X); } SEAM(8);
    if (IN(9)) {
        LAS int* tile_e = (LAS int*)(X.lds + L_MISC); LAS int* pstart = tile_e + 256;
        const int ntiles = moe_tiles(X, tile_e, pstart);
        pg8::Gemm g{(const bf16*)(X.a->ws + WS_XS), (const bf16*)(X.a->ws + WS_WGU), ntiles * 256, 1024, D, D};
        pg8::MoeOrder S; S.base.init(ntiles * 256, 1024, X.G, (int)blockIdx.x); S.tile_e = tile_e;
        pg8::EpiGU E{(bf16*)(X.a->ws + WS_HS)};
        pg8::gemm_phase<pg8::EpiGU, pg8::MoeOrder, true, true>(X.lds, g, S, E);
    } SEAM(9);
    if (IN(10)) {
        LAS int* tile_e = (LAS int*)(X.lds + L_MISC); LAS int* pstart = tile_e + 256;
        const int ntiles = moe_tiles(X, tile_e, pstart);
        pg8::Gemm g{(const bf16*)(X.a->ws + WS_HS), (const bf16*)(X.a->ws + WS_WD), ntiles * 256, 1024, 512, 512};
        pg8::MoeOrder S; S.base.init(ntiles * 256, 1024, X.G, (int)blockIdx.x); S.tile_e = tile_e;
        pg8::EpiDown E{(bf16*)(X.a->ws + WS_XS), (const float*)(X.a->ws + WS_ROUTE + RT_SGATE)};
        pg8::gemm_phase<pg8::EpiDown, pg8::MoeOrder, true, true>(X.lds, g, S, E);
    } SEAM(10);
    if (IN(11)) { moe_final(X); }
#ifdef PROBE_A
    if (blockIdx.x == 0 && X.tid == 0) { const unsigned long long tend = __builtin_amdgcn_s_memrealtime(); STAMP[12] = tend;
        const unsigned long long spin_ticks = 64ull * (PROBE_A == 99 ? (STAMP[12] - STAMP[0]) : PROBE_A == 70 ? (STAMP[13] - STAMP[7]) : PROBE_A >= 200 ? ((volatile LAS unsigned long long*)(X.lds + L_CTL + 384))[PROBE_A - 200] : (STAMP[PROBE_A + 1] - STAMP[PROBE_A]));
        while (__builtin_amdgcn_s_memrealtime() - tend < spin_ticks) __builtin_amdgcn_s_sleep(32); }
#endif
#undef IN
#undef SEAM
}

extern "C" void kernel_launch(void* const* d_in, const int* in_sizes, int n_in, void* d_out, int out_size, void* d_ws, size_t ws_size, hipStream_t stream) {
    static int grid = 0;
    if (grid == 0) {
        if (n_in != 35 || out_size != MLAT * D || ws_size < WS_NEED) { fprintf(stderr, "kernel_launch: unexpected problem (n_in %d, out %d, ws %zu < %zu)\n", n_in, out_size, ws_size, (size_t)WS_NEED); grid = -1; return; }
        int dev = 0, cus = 0;
        if (hipGetDevice(&dev) != hipSuccess || hipDeviceGetAttribute(&cus, hipDeviceAttributeMultiprocessorCount, dev) != hipSuccess) { grid = -1; return; }
        if (hipFuncSetAttribute((const void*)fwd_kernel, hipFuncAttributeMaxDynamicSharedMemorySize, LDS_BYTES) != hipSuccess) { fprintf(stderr, "kernel_launch: hipFuncSetAttribute failed\n"); grid = -1; return; }
        (void)hipGetLastError();
        grid = cus;
    }
    if (grid < 0) return;
    if (hipMemsetAsync((char*)d_ws + WS_CTL, 0, CTL_ZERO_BYTES, stream) != hipSuccess) return;
    Args a{};
    for (int i = 0; i < 35; ++i) a.in[i] = (const float*)d_in[i];
    a.out = (float*)d_out; a.ws = (unsigned char*)d_ws;
    if (N_LAUNCHES == 1) { a.ph_lo = 0; a.ph_hi = NPHASE; hipLaunchKernelGGL(fwd_kernel, dim3(grid), dim3(NTHR), LDS_BYTES, stream, a); }
    else for (int p = 0; p < NPHASE; ++p) { a.ph_lo = p; a.ph_hi = p + 1; hipLaunchKernelGGL(fwd_kernel, dim3(grid), dim3(NTHR), LDS_BYTES, stream, a); }
}
```
